# Optimizing an MI355X kernel written in HIP

```python
import math
import jax, jax.numpy as jnp
from jax import lax
import numpy as np

D_MODEL = 2048
BATCH = 1
SEQ = 16384
DEPTH = 2

GRID_W = 64
BLOCK_Q = 128
ROPE_THETA = 10000.0
NORM_EPS = 1e-6
LN_EPS = 1e-5

HEAD_DIM = 128
GQA_Q_HEADS = 8
GQA_KV_HEADS = 2
DIFF_HEADS = 4
DIFF_HEAD_DIM = 128
A_Q = GQA_Q_HEADS * HEAD_DIM
A_KV = GQA_KV_HEADS * HEAD_DIM
B_QK = DIFF_HEADS * 2 * DIFF_HEAD_DIM
B_V = DIFF_HEADS * 2 * DIFF_HEAD_DIM
AB_IN = A_Q + 2 * A_KV + 2 * B_QK + B_V
MIX_WIDTH = A_Q + B_V

MLA_HEADS = 16
MLA_Q_RANK = 512
MLA_KV_RANK = 512
MLA_NOPE = 128
MLA_ROPE = 64
MLA_V = 128
MLA_IN = MLA_Q_RANK + MLA_KV_RANK + MLA_ROPE
MLA_OUT = MLA_HEADS * MLA_V

N_EXPERTS = 16
EXPERT_FF = 2048
EC_FACTOR = 2

DEEPNORM_ALPHA = (2 * DEPTH) ** 0.25
DEEPNORM_BETA = (8 * DEPTH) ** -0.25
N_EVEN = (DEPTH + 1) // 2
N_ODD = DEPTH // 2

kernel_name = "hybrid_gqa_diff_mla_ec_moe_deepnorm"


def rms_norm(x, w):
    xf = x.astype(jnp.float32)
    y = xf * lax.rsqrt(jnp.mean(xf * xf, axis=-1, keepdims=True) + NORM_EPS)
    return (y * w.astype(jnp.float32)).astype(x.dtype)


def layer_norm(x, g, b):
    xf = x.astype(jnp.float32)
    mu = jnp.mean(xf, axis=-1, keepdims=True)
    var = jnp.mean(jnp.square(xf - mu), axis=-1, keepdims=True)
    y = (xf - mu) * lax.rsqrt(var + LN_EPS) * g.astype(jnp.float32) + b.astype(jnp.float32)
    return y.astype(x.dtype)


def grid_positions(S):
    n_rows = S // GRID_W
    row = jnp.repeat(jnp.arange(n_rows, dtype=jnp.int32), GRID_W)
    col = jnp.tile(jnp.arange(GRID_W, dtype=jnp.int32), n_rows)
    return row, col


def _rotate(xs, pos):
    n = xs.shape[-1]
    freqs = ROPE_THETA ** (-jnp.arange(0, n, 2, dtype=jnp.float32) / n)
    ang = pos.astype(jnp.float32)[:, None] * freqs[None, :]
    cos = jnp.cos(ang)[:, None, :].astype(xs.dtype)
    sin = jnp.sin(ang)[:, None, :].astype(xs.dtype)
    x1, x2 = jnp.split(xs, 2, axis=-1)
    return jnp.concatenate([x1 * cos - x2 * sin, x2 * cos + x1 * sin], axis=-1)


def axial_rope(x, row, col):
    half = x.shape[-1] // 2
    return jnp.concatenate([_rotate(x[..., :half], row), _rotate(x[..., half:], col)], axis=-1)


def to_blocks(t):
    B, S = t.shape[:2]
    return jnp.moveaxis(t.reshape((B, S // BLOCK_Q, BLOCK_Q) + t.shape[2:]), 1, 0)


def from_blocks(t):
    nb, B, bq = t.shape[:3]
    return jnp.moveaxis(t, 0, 1).reshape((B, nb * bq) + t.shape[3:])


def grouped_attention(q, k, v):
    B, S, Hq, D = q.shape
    G = k.shape[2]
    R = Hq // G
    scale = D ** -0.5
    qb = to_blocks(q.reshape(B, S, G, R, D))

    def one_block(qblk):
        s = jnp.einsum('bqgrd,bkgd->bgrqk', qblk, k, preferred_element_type=jnp.float32) * scale
        p = jax.nn.softmax(s, axis=-1).astype(v.dtype)
        return jnp.einsum('bgrqk,bkgd->bqgrd', p, v)

    out = from_blocks(lax.map(one_block, qb))
    return out.reshape(B, S, -1)


def differential_attention(q1, q2, k1, k2, v, lam, slopes):
    S = q1.shape[1]
    scale = q1.shape[-1] ** -0.5
    t_k = jnp.arange(S, dtype=jnp.int32)
    starts = jnp.arange(S // BLOCK_Q, dtype=jnp.int32) * BLOCK_Q

    def one_block(args):
        q1b, q2b, start = args
        t_q = start + jnp.arange(BLOCK_Q, dtype=jnp.int32)
        dist = jnp.abs(t_q[:, None] - t_k[None, :]).astype(jnp.float32)
        bias = -slopes[:, None, None] * dist[None]
        s1 = jnp.einsum('bqhd,bkhd->bhqk', q1b, k1, preferred_element_type=jnp.float32) * scale + bias
        s2 = jnp.einsum('bqhd,bkhd->bhqk', q2b, k2, preferred_element_type=jnp.float32) * scale + bias
        attn = (jax.nn.softmax(s1, axis=-1) - lam * jax.nn.softmax(s2, axis=-1)).astype(v.dtype)
        return jnp.einsum('bhqk,bkhd->bqhd', attn, v)

    return from_blocks(lax.map(one_block, (to_blocks(q1), to_blocks(q2), starts)))


def even_mixer(x, row, col, w_in, q_norm, k_norm, lq1, lk1, lq2, lk2, subln, w_out, lam_init):
    B, S, _ = x.shape
    h = x @ w_in
    cuts = np.cumsum([A_Q, A_KV, A_KV, B_QK, B_QK]).tolist()
    aq, ak, av, bq, bk, bv = jnp.split(h, cuts, axis=-1)
    aq = axial_rope(rms_norm(aq.reshape(B, S, GQA_Q_HEADS, HEAD_DIM), q_norm), row, col)
    ak = axial_rope(rms_norm(ak.reshape(B, S, GQA_KV_HEADS, HEAD_DIM), k_norm), row, col)
    av = av.reshape(B, S, GQA_KV_HEADS, HEAD_DIM)
    a_out = grouped_attention(aq, ak, av)
    bq = bq.reshape(B, S, DIFF_HEADS, 2, DIFF_HEAD_DIM)
    bk = bk.reshape(B, S, DIFF_HEADS, 2, DIFF_HEAD_DIM)
    bv = bv.reshape(B, S, DIFF_HEADS, 2 * DIFF_HEAD_DIM)
    lam = (jnp.exp(jnp.sum(lq1.astype(jnp.float32) * lk1.astype(jnp.float32)))
           - jnp.exp(jnp.sum(lq2.astype(jnp.float32) * lk2.astype(jnp.float32))) + lam_init)
    slopes = 2.0 ** (-8.0 * jnp.arange(1, DIFF_HEADS + 1, dtype=jnp.float32) / DIFF_HEADS)
    b_out = differential_attention(bq[..., 0, :], bq[..., 1, :], bk[..., 0, :], bk[..., 1, :],
                                   bv, lam, slopes)
    b_out = (rms_norm(b_out, subln) * (1.0 - lam_init)).reshape(B, S, B_V)
    return jnp.concatenate([a_out, b_out], axis=-1) @ w_out


def odd_mixer(x, row, col, w_in, q_norm, kv_norm, w_uq, w_ukv, w_out):
    B, S, _ = x.shape
    h = x @ w_in
    c_q, c_kv, k_rope = jnp.split(h, [MLA_Q_RANK, MLA_Q_RANK + MLA_KV_RANK], axis=-1)
    q = (rms_norm(c_q, q_norm) @ w_uq).reshape(B, S, MLA_HEADS, MLA_NOPE + MLA_ROPE)
    q = jnp.concatenate([q[..., :MLA_NOPE], axial_rope(q[..., MLA_NOPE:], row, col)], axis=-1)
    kv = (rms_norm(c_kv, kv_norm) @ w_ukv).reshape(B, S, MLA_HEADS, MLA_NOPE + MLA_V)
    k_nope, v = kv[..., :MLA_NOPE], kv[..., MLA_NOPE:]
    k_rope = axial_rope(k_rope[:, :, None, :], row, col)
    k = jnp.concatenate([k_nope, jnp.broadcast_to(k_rope, (B, S, MLA_HEADS, MLA_ROPE))], axis=-1)
    return grouped_attention(q, k, v) @ w_out


def expert_choice_ffn(x, w_router, w_gate, w_up, w_down):
    B, S, _ = x.shape
    cap = EC_FACTOR * S // N_EXPERTS
    aff = jax.nn.softmax((x @ w_router).astype(jnp.float32), axis=-1)
    g, idx = lax.top_k(jnp.swapaxes(aff, 1, 2), cap)
    bidx = jnp.arange(B)[:, None, None]
    xin = x[bidx, idx]
    hid = jax.nn.silu(jnp.einsum('becd,edf->becf', xin, w_gate)) * jnp.einsum('becd,edf->becf', xin, w_up)
    y = jnp.einsum('becf,efd->becd', hid, w_down) * g[..., None].astype(x.dtype)
    return jnp.zeros_like(x).at[bidx, idx].add(y)


def setup_inputs(seed: int = 0) -> dict:
    key = jax.random.key(seed)
    ks = iter(jax.random.split(key, 40))
    f32 = jnp.float32

    def nrm(shape, scale):
        return jax.random.normal(next(ks), shape, f32) * scale

    def gain(shape):
        return 1.0 + nrm(shape, 0.02)

    return {
        "x": nrm((BATCH, SEQ, D_MODEL), 1.0),
        "ab_w_in": nrm((N_EVEN, D_MODEL, AB_IN), D_MODEL ** -0.5),
        "ab_q_norm": gain((N_EVEN, HEAD_DIM)),
        "ab_k_norm": gain((N_EVEN, HEAD_DIM)),
        "ab_lambda_q1": nrm((N_EVEN, DIFF_HEAD_DIM), 0.1),
        "ab_lambda_k1": nrm((N_EVEN, DIFF_HEAD_DIM), 0.1),
        "ab_lambda_q2": nrm((N_EVEN, DIFF_HEAD_DIM), 0.1),
        "ab_lambda_k2": nrm((N_EVEN, DIFF_HEAD_DIM), 0.1),
        "ab_subln": gain((N_EVEN, 2 * DIFF_HEAD_DIM)),
        "ab_w_out": nrm((N_EVEN, MIX_WIDTH, D_MODEL), MIX_WIDTH ** -0.5 * DEEPNORM_BETA),
        "mla_w_in": nrm((N_ODD, D_MODEL, MLA_IN), D_MODEL ** -0.5),
        "mla_q_norm": gain((N_ODD, MLA_Q_RANK)),
        "mla_kv_norm": gain((N_ODD, MLA_KV_RANK)),
        "mla_w_uq": nrm((N_ODD, MLA_Q_RANK, MLA_HEADS * (MLA_NOPE + MLA_ROPE)), MLA_Q_RANK ** -0.5),
        "mla_w_ukv": nrm((N_ODD, MLA_KV_RANK, MLA_HEADS * (MLA_NOPE + MLA_V)), MLA_KV_RANK ** -0.5),
        "mla_w_out": nrm((N_ODD, MLA_OUT, D_MODEL), MLA_OUT ** -0.5 * DEEPNORM_BETA),
        "ln_mix_g": gain((DEPTH, D_MODEL)),
        "ln_mix_b": nrm((DEPTH, D_MODEL), 0.02),
        "moe_w_router": nrm((DEPTH, D_MODEL, N_EXPERTS), D_MODEL ** -0.5),
        "moe_w_gate": nrm((DEPTH, N_EXPERTS, D_MODEL, EXPERT_FF), D_MODEL ** -0.5),
        "moe_w_up": nrm((DEPTH, N_EXPERTS, D_MODEL, EXPERT_FF), D_MODEL ** -0.5),
        "moe_w_down": nrm((DEPTH, N_EXPERTS, EXPERT_FF, D_MODEL), EXPERT_FF ** -0.5 * DEEPNORM_BETA),
        "ln_ffn_g": gain((DEPTH, D_MODEL)),
        "ln_ffn_b": nrm((DEPTH, D_MODEL), 0.02),
    }


def reference(x, ab_w_in, ab_q_norm, ab_k_norm, ab_lambda_q1, ab_lambda_k1, ab_lambda_q2,
              ab_lambda_k2, ab_subln, ab_w_out, mla_w_in, mla_q_norm, mla_kv_norm, mla_w_uq,
              mla_w_ukv, mla_w_out, ln_mix_g, ln_mix_b, moe_w_router, moe_w_gate, moe_w_up,
              moe_w_down, ln_ffn_g, ln_ffn_b):
    S = x.shape[1]
    row, col = grid_positions(S)
    for layer in range(DEPTH):
        if layer % 2 == 0:
            i = layer // 2
            lam_init = 0.8 - 0.6 * math.exp(-0.3 * layer)
            mix = even_mixer(x, row, col, ab_w_in[i], ab_q_norm[i], ab_k_norm[i],
                             ab_lambda_q1[i], ab_lambda_k1[i], ab_lambda_q2[i], ab_lambda_k2[i],
                             ab_subln[i], ab_w_out[i], lam_init)
        else:
            i = layer // 2
            mix = odd_mixer(x, row, col, mla_w_in[i], mla_q_norm[i], mla_kv_norm[i],
                            mla_w_uq[i], mla_w_ukv[i], mla_w_out[i])
        x = layer_norm(DEEPNORM_ALPHA * x + mix, ln_mix_g[layer], ln_mix_b[layer])
        ffn = expert_choice_ffn(x, moe_w_router[layer], moe_w_gate[layer], moe_w_up[layer],
                                moe_w_down[layer])
        x = layer_norm(DEEPNORM_ALPHA * x + ffn, ln_ffn_g[layer], ln_ffn_b[layer])
    return x
```

```cpp
#include <hip/hip_runtime.h>
#include <cstdio>
#include <cstdint>

#ifndef MK_ONE_LAUNCH
#define MK_ONE_LAUNCH 1
#endif

#define GAS __attribute__((address_space(1)))
#define LAS __attribute__((address_space(3)))
typedef unsigned short bf16_t;
typedef short bf16x8 __attribute__((ext_vector_type(8)));
typedef short s16x4 __attribute__((ext_vector_type(4)));
typedef float f32x4 __attribute__((ext_vector_type(4)));
typedef float f32x2 __attribute__((ext_vector_type(2)));
typedef float f32x16 __attribute__((ext_vector_type(16)));
typedef unsigned u32x4 __attribute__((ext_vector_type(4)));
typedef unsigned u32x2 __attribute__((ext_vector_type(2)));
typedef int v8i_t __attribute__((ext_vector_type(8)));

constexpr int S = 16384, DM = 2048, GRIDW = 64;
constexpr int AB_IN = 4608, NE = 16, FF = 2048, CAP = 2048;
constexpr int MLA_IN_PAD = 1280;
constexpr float ALPHA = 1.4142135623730951f;
constexpr float NORM_EPS = 1e-6f, LN_EPS = 1e-5f;
constexpr int NWAVES = 8, NTHR = 512;

constexpr size_t MiB = 1u << 20;
constexpr size_t WS_CTL = 0, CTL_ZERO_BYTES = 1 * MiB;
constexpr size_t WS_TAB = 1 * MiB;
constexpr size_t WS_SEL = 2 * MiB;
constexpr size_t WS_WIN = 6 * MiB, WS_WOUT = 24 * MiB, WS_WMIN = 32 * MiB, WS_WUQ = 37 * MiB, WS_WUKV = 40 * MiB, WS_WMOUT = 44 * MiB;
constexpr size_t WS_WGU = 52 * MiB, WS_WD = 564 * MiB;
constexpr size_t WS_XB = 820 * MiB, WS_X1 = 884 * MiB, WS_X2 = 1012 * MiB, WS_SCR = 1140 * MiB, WS_END = 1652 * MiB;
constexpr size_t SC_HQK = 0, SC_HB = 80 * MiB, SC_AQB = 184 * MiB, SC_AKB = 216 * MiB, SC_DO = 224 * MiB, SC_CAT = 352 * MiB;
constexpr size_t SC_XIN = 0, SC_HID = 128 * MiB, SC_YS = 256 * MiB;
constexpr size_t SC_H1 = 0, SC_CQN = 80 * MiB, SC_CKVN = 96 * MiB, SC_KROPE = 112 * MiB, SC_QM = 114 * MiB, SC_KVM = 210 * MiB, SC_AO = 338 * MiB;
constexpr int HB_LD = 3328;
constexpr size_t SEL_IDX = 0, SEL_GATE = 128 * 1024, SEL_TOKSLOT = 256 * 1024, SEL_AFF = 256 * 1024 + 1 * MiB;
constexpr int TAB_R128 = 0, TAB_C128 = 256 * 32, TAB_R64 = TAB_C128 + 64 * 32, TAB_C64 = TAB_R64 + 256 * 16, TAB_N = TAB_C64 + 64 * 16;
constexpr int CW_BAR = 16384;
constexpr int CW_QHEAD0 = 8192, CW_NORM2 = 8256, CW_AFLAG = 8320;
constexpr int CW_QHEAD0_ = 0;

constexpr int RING_OFF = 0, RING_BYTES = 131072;
constexpr int LDSCTL_OFF = 161792, MISC_OFF = LDSCTL_OFF + 320;
constexpr int LDS_BYTES = 163840;

#define RLX_AGENT __ATOMIC_RELAXED, __HIP_MEMORY_SCOPE_AGENT
#define LDS_WAIT() asm volatile("s_waitcnt lgkmcnt(0)" ::: "memory")
#define VM_WAIT() asm volatile("s_waitcnt vmcnt(0)" ::: "memory")
__device__ __forceinline__ unsigned f2bf(float f) { unsigned u = __builtin_bit_cast(unsigned, f); return (u + 0x7fffu + ((u >> 16) & 1u)) >> 16; }
__device__ __forceinline__ unsigned pk2(float lo, float hi) { return f2bf(lo) | (f2bf(hi) << 16); }
__device__ __forceinline__ float bf2f(unsigned short b) { return __builtin_bit_cast(float, ((unsigned)b) << 16); }
__device__ __forceinline__ unsigned cvt_pk_bf16(float lo, float hi) { unsigned r; asm volatile("v_cvt_pk_bf16_f32 %0, %1, %2" : "=v"(r) : "v"(lo), "v"(hi)); return r; }
__device__ __forceinline__ float wave_sum(float v) {
#pragma unroll
    for (int o = 1; o < 64; o <<= 1) v += __shfl_xor(v, o);
    return v;
}
__device__ __forceinline__ float wave_max(float v) {
#pragma unroll
    for (int o = 1; o < 64; o <<= 1) v = fmaxf(v, __shfl_xor(v, o));
    return v;
}

__device__ __forceinline__ float clamp8(float x) { return fminf(fmaxf(x, -448.f), 448.f); }
__device__ __forceinline__ unsigned pk4_fp8(float a, float b, float c, float d) {
    int w = __builtin_amdgcn_cvt_pk_fp8_f32(clamp8(a), clamp8(b), 0, false); w = __builtin_amdgcn_cvt_pk_fp8_f32(clamp8(c), clamp8(d), w, true); return (unsigned)w; }
constexpr float W8_GU = 32.f, W8_D = 64.f;
#define XB_TMO      128
#define XB_XCNT(j)  (256  + 64 * (j))
#define XB_XSUB(j)  (1280 + 64 * (j))
#define XB_XGEN(j)  (2304 + 64 * (j))
#define XB_TOP      3328
#define XB_TOPGEN   3392
#define XCD_BAR_WORDS 3456
#define XB_SPIN_CAP (1u << 20)

__device__ __forceinline__ unsigned xb_ld(unsigned* p)              { return __hip_atomic_load(p, __ATOMIC_RELAXED, __HIP_MEMORY_SCOPE_AGENT); }
__device__ __forceinline__ unsigned xb_add(unsigned* p, unsigned v) { return __hip_atomic_fetch_add(p, v, __ATOMIC_RELAXED, __HIP_MEMORY_SCOPE_AGENT); }
__device__ __forceinline__ unsigned xb_xcc_id() { return (unsigned)__builtin_amdgcn_s_getreg((3 << 11) | 20) & 0xFu; }
#define XB_SPIN(cond, bar) do { unsigned _sp = 0; while (cond) { __builtin_amdgcn_s_sleep(1); \
    if ((++_sp & 255u) == 0u) { if (xb_ld(&(bar)[XB_TMO])) break; if (_sp > XB_SPIN_CAP) { atomicAdd(&(bar)[XB_TMO], 1u); break; } } } } while (0)

struct XcdBarrier { unsigned* bar; unsigned x; volatile LAS unsigned* st; };

__device__ __forceinline__ XcdBarrier xcd_barrier_post(unsigned* bar, volatile LAS unsigned* st) {
    XcdBarrier b; b.bar = bar; b.x = xb_xcc_id(); b.st = st;
    if (threadIdx.x == 0) (void)xb_add(&bar[XB_XCNT(b.x)], 1u);
    return b;
}
__device__ __forceinline__ void xcd_barrier_complete(unsigned* bar, unsigned x, unsigned& nloc, unsigned& nx) {
    const unsigned G = gridDim.x * gridDim.y * gridDim.z;
    unsigned sum, cnt, mine, sp = 0u;
    for (;;) {
        sum = 0u; cnt = 0u; mine = 0u;
#pragma unroll
        for (unsigned j = 0; j < 16; ++j) { const unsigned c = xb_ld(&bar[XB_XCNT(j)]); sum += c; cnt += (c > 0u) ? 1u : 0u; mine = (j == x) ? c : mine; }
        if (sum == G) break;
        __builtin_amdgcn_s_sleep(1);
        if ((++sp & 255u) == 0u) { if (xb_ld(&bar[XB_TMO])) break; if (sp > XB_SPIN_CAP) { atomicAdd(&bar[XB_TMO], 1u); break; } }
    }
    nloc = mine > 0u ? mine : 1u; nx = cnt > 0u ? cnt : 1u;
}
__device__ __forceinline__ void xcd_barrier(const XcdBarrier& b) {
    asm volatile("s_waitcnt vmcnt(0)" ::: "memory");
    __syncthreads();
    if (threadIdx.x == 0) {
        unsigned* bar = b.bar; unsigned bx = b.x;
        asm volatile("" : "+s"(bar), "+s"(bx));
        __builtin_amdgcn_s_waitcnt(0);
        unsigned nloc = b.st[0], nx = b.st[1];
        if (nloc == 0u) { xcd_barrier_complete(bar, bx, nloc, nx); b.st[0] = nloc; b.st[1] = nx; }
        const unsigned old = xb_add(&bar[XB_XSUB(bx)], 1u);
        const unsigned gen = old / nloc;
        if (old + 1u == (gen + 1u) * nloc) {
            __builtin_amdgcn_fence(__ATOMIC_RELEASE, "agent");
            asm volatile("s_waitcnt vmcnt(0)" ::: "memory");
            const unsigned og = xb_add(&bar[XB_TOP], 1u);
            const unsigned tg = og / nx;
            if (og + 1u == (tg + 1u) * nx) xb_add(&bar[XB_TOPGEN], 1u);
            else XB_SPIN(xb_ld(&bar[XB_TOPGEN]) == tg, bar);
            __builtin_amdgcn_fence(__ATOMIC_ACQUIRE, "agent");
            xb_add(&bar[XB_XGEN(bx)], 1u);
            asm volatile("s_waitcnt vmcnt(0)" ::: "memory");
        } else {
            XB_SPIN(xb_ld(&bar[XB_XGEN(bx)]) == gen, bar);
            __builtin_amdgcn_fence(__ATOMIC_ACQUIRE, "agent");
            asm volatile("s_waitcnt vmcnt(0)" ::: "memory");
        }
    }
    __syncthreads();
}

namespace pg8 {
constexpr int BM = 256, BK = 64, HALF = 128, HTB = HALF * BK * 2, STAGE_BYTES = 8 * HTB, NXCD = 8, WGM = 8;
__host__ __device__ __forceinline__ int lds_byte(int r, int c) { const int st = (r >> 4) * 2 + (c >> 5), rr = r & 15, cc = c & 31, ob = rr * 64 + cc * 2; return st * 1024 + (ob ^ (((ob >> 9) & 1) << 5)); }
__host__ __device__ __forceinline__ void stage_rc(int b, int& R, int& C) { const int st = b / 1024, sb = b % 1024, swz = sb ^ (((sb >> 9) & 1) << 5); R = (st >> 1) * 16 + swz / 64; C = (st & 1) * 32 + (swz % 64) / 2; }
__host__ __device__ __forceinline__ int perm32(int rho) { const int n = rho >> 4, i = rho & 15; return 8 * (i >> 2) + 4 * n + (i & 3); }

struct Unit { int pm, pn; };
struct Gemm { const bf16_t* A; const bf16_t* Bt; int M, N, K; const int* idx; };

struct StaticOrder {
    int nM, nN, nwg, G, c;
    __device__ void init(int M, int N, int G_, int c_) { nM = M / BM; nN = N / BM; nwg = nM * nN; G = G_; c = c_; }
    __device__ bool next(int i, Unit& u) const {
        const long L = (long)i * G + c; if (L >= nwg) return false;
        int wgid = (int)L; { const int q = nwg / NXCD, r = nwg % NXCD, xcd = wgid % NXCD, off = wgid / NXCD; wgid = (xcd < r ? xcd * (q + 1) : r * (q + 1) + (xcd - r) * q) + off; }
        const int nig = WGM * nN, gid = wgid / nig, fm = gid * WGM, gsz = (nM - fm) < WGM ? (nM - fm) : WGM;
        u.pm = fm + ((wgid % nig) % gsz); u.pn = (wgid % nig) / gsz; return true;
    }
    __device__ __forceinline__ void a_ready(const Unit&) const {}
    __device__ __forceinline__ void done(const Unit&) const {}
};
struct GroupOrder {
    int G, c, per_e, nnt;
    __device__ void init(int nnt_, int G_, int c_) { nnt = nnt_; per_e = 8 * nnt_; G = G_; c = c_; }
    __device__ bool next(int i, Unit& u) const {
        const long L = (long)i * G + c; if (L >= (long)NE * per_e) return false;
        const int e = (int)L / per_e, r = (int)L % per_e;
        u.pm = e * 8 + (r % 8); u.pn = e * nnt + (r / 8); return true;
    }
    __device__ __forceinline__ void a_ready(const Unit&) const {}
    __device__ __forceinline__ void done(const Unit&) const {}
};

struct EpiBf16 {
    static constexpr bool PERM = true, AFTER_DRAIN = false;
    bf16_t* O; int ldc;
    __device__ __forceinline__ void operator()(const f32x4 (&acc)[2][2][4][2], const Unit& u, int wr, int wc, int fr, int fq) const {
        const int row0 = u.pm * BM + wr * 64 + fr, col0 = u.pn * BM + wc * 32 + 8 * fq;
#pragma unroll
        for (int ai = 0; ai < 2; ++ai)
#pragma unroll
            for (int m = 0; m < 4; ++m) { bf16_t* rowp = O + (size_t)(row0 + ai * HALF + m * 16) * ldc + col0;
#pragma unroll
                for (int bj = 0; bj < 2; ++bj) { const f32x4 v0 = acc[ai][bj][m][0], v1 = acc[ai][bj][m][1];
                    u32x4 w; w.x = cvt_pk_bf16(v0[0], v0[1]); w.y = cvt_pk_bf16(v0[2], v0[3]); w.z = cvt_pk_bf16(v1[0], v1[1]); w.w = cvt_pk_bf16(v1[2], v1[3]);
                    *(u32x4*)(rowp + bj * HALF) = w; } }
    }
};
struct UpOrder {
    int G, c;
    __device__ void init(int G_, int c_) { G = G_; c = c_; }
    __device__ bool next(int i, Unit& u) const {
        const int L = i * G + c; if (L >= 1792) return false;
        if (L < 768) { u.pm = L & 63; u.pn = L >> 6; } else { const int r = L - 768; u.pm = 64 + (r & 63); u.pn = 12 + (r >> 6); }
        return true;
    }
    __device__ __forceinline__ void a_ready(const Unit&) const {}
    __device__ __forceinline__ void done(const Unit&) const {}
};
struct EpiUp {
    static constexpr bool PERM = true, AFTER_DRAIN = false;
    bf16_t* QM; bf16_t* KVM;
    __device__ __forceinline__ void operator()(const f32x4 (&acc)[2][2][4][2], const Unit& u, int wr, int wc, int fr, int fq) const {
        const bool isq = u.pn < 12;
        bf16_t* O = isq ? QM : KVM; const int ldc = isq ? 3072 : 4096;
        const int row0 = (isq ? u.pm : u.pm - 64) * BM + wr * 64 + fr, col0 = (isq ? u.pn : u.pn - 12) * BM + wc * 32 + 8 * fq;
#pragma unroll
        for (int ai = 0; ai < 2; ++ai)
#pragma unroll
            for (int m = 0; m < 4; ++m) { bf16_t* rowp = O + (size_t)(row0 + ai * HALF + m * 16) * ldc + col0;
#pragma unroll
                for (int bj = 0; bj < 2; ++bj) { const f32x4 v0 = acc[ai][bj][m][0], v1 = acc[ai][bj][m][1];
                    u32x4 w; w.x = cvt_pk_bf16(v0[0], v0[1]); w.y = cvt_pk_bf16(v0[2], v0[3]); w.z = cvt_pk_bf16(v1[0], v1[1]); w.w = cvt_pk_bf16(v1[2], v1[3]);
                    *(u32x4*)(rowp + bj * HALF) = w; } }
    }
};
struct EpiF32 {
    static constexpr bool PERM = true, AFTER_DRAIN = false;
    float* C; int ldc;
    __device__ __forceinline__ void operator()(const f32x4 (&acc)[2][2][4][2], const Unit& u, int wr, int wc, int fr, int fq) const {
        const int row0 = u.pm * BM + wr * 64 + fr, col0 = u.pn * BM + wc * 32 + 8 * fq;
#pragma unroll
        for (int ai = 0; ai < 2; ++ai)
#pragma unroll
            for (int m = 0; m < 4; ++m) { float* rowp = C + (size_t)(row0 + ai * HALF + m * 16) * ldc + col0;
#pragma unroll
                for (int bj = 0; bj < 2; ++bj) { *(f32x4*)(rowp + bj * HALF) = acc[ai][bj][m][0]; *(f32x4*)(rowp + bj * HALF + 4) = acc[ai][bj][m][1]; } }
    }
};
struct EpiIn0 {
    static constexpr bool PERM = true, AFTER_DRAIN = false;
    float* F; bf16_t* B;
    __device__ __forceinline__ void operator()(const f32x4 (&acc)[2][2][4][2], const Unit& u, int wr, int wc, int fr, int fq) const {
        const int row0 = u.pm * BM + wr * 64 + fr, c0 = wc * 32 + 8 * fq;
        if (u.pn < 5) {
#pragma unroll
            for (int ai = 0; ai < 2; ++ai)
#pragma unroll
                for (int m = 0; m < 4; ++m) { float* rowp = F + (size_t)(row0 + ai * HALF + m * 16) * 1280 + u.pn * BM + c0;
#pragma unroll
                    for (int bj = 0; bj < 2; ++bj) { *(f32x4*)(rowp + bj * HALF) = acc[ai][bj][m][0]; *(f32x4*)(rowp + bj * HALF + 4) = acc[ai][bj][m][1]; } }
        } else {
#pragma unroll
            for (int ai = 0; ai < 2; ++ai)
#pragma unroll
                for (int m = 0; m < 4; ++m) { bf16_t* rowp = B + (size_t)(row0 + ai * HALF + m * 16) * HB_LD + (u.pn * BM - 1280) + c0;
#pragma unroll
                    for (int bj = 0; bj < 2; ++bj) { const f32x4 v0 = acc[ai][bj][m][0], v1 = acc[ai][bj][m][1];
                        u32x4 w; w.x = cvt_pk_bf16(v0[0], v0[1]); w.y = cvt_pk_bf16(v0[2], v0[3]); w.z = cvt_pk_bf16(v1[0], v1[1]); w.w = cvt_pk_bf16(v1[2], v1[3]);
                        *(u32x4*)(rowp + bj * HALF) = w; } }
        }
    }
};
struct EpiResid {
    static constexpr bool PERM = true, AFTER_DRAIN = false;
    const float* R; float* Y;
    __device__ __forceinline__ void operator()(const f32x4 (&acc)[2][2][4][2], const Unit& u, int wr, int wc, int fr, int fq) const {
        const int row0 = u.pm * BM + wr * 64 + fr, col0 = u.pn * BM + wc * 32 + 8 * fq;
#pragma unroll
        for (int ai = 0; ai < 2; ++ai)
#pragma unroll
            for (int m = 0; m < 4; ++m) { const size_t off = (size_t)(row0 + ai * HALF + m * 16) * DM + col0;
#pragma unroll
                for (int bj = 0; bj < 2; ++bj) { const f32x4 r0 = *(const f32x4*)(R + off + bj * HALF), r1 = *(const f32x4*)(R + off + bj * HALF + 4);
                    *(f32x4*)(Y + off + bj * HALF) = r0 * ALPHA + acc[ai][bj][m][0]; *(f32x4*)(Y + off + bj * HALF + 4) = r1 * ALPHA + acc[ai][bj][m][1]; } }
    }
};
__device__ __forceinline__ float silu_mul(float g, float u) { return g * __builtin_amdgcn_rcpf(1.f + __builtin_amdgcn_exp2f(-1.4426950408889634f * g)) * u; }
struct EpiSwiglu {
    static constexpr bool PERM = true, AFTER_DRAIN = false;
    unsigned char* H;
    __device__ __forceinline__ void operator()(const f32x4 (&acc)[2][2][4][2], const Unit& u, int wr, int wc, int fr, int fq) const {
        const int row0 = u.pm * BM + wr * 64 + fr, col0 = (u.pn & 15) * HALF + wc * 32 + 8 * fq;
        constexpr float is = 1.f / W8_GU;
#pragma unroll
        for (int ai = 0; ai < 2; ++ai)
#pragma unroll
            for (int m = 0; m < 4; ++m) { unsigned char* p = H + (unsigned)((row0 + ai * HALF + m * 16) * FF + col0);
                const f32x4 g0 = acc[ai][0][m][0] * is, g1 = acc[ai][0][m][1] * is, u0 = acc[ai][1][m][0] * is, u1 = acc[ai][1][m][1] * is;
                u32x2 w; w.x = pk4_fp8(silu_mul(g0[0], u0[0]), silu_mul(g0[1], u0[1]), silu_mul(g0[2], u0[2]), silu_mul(g0[3], u0[3]));
                w.y = pk4_fp8(silu_mul(g1[0], u1[0]), silu_mul(g1[1], u1[1]), silu_mul(g1[2], u1[2]), silu_mul(g1[3], u1[3]));
                *(u32x2*)p = w; }
    }
};
struct EpiDown {
    static constexpr bool PERM = true, AFTER_DRAIN = false;
    bf16_t* Y; const float* gate;
    __device__ __forceinline__ void operator()(const f32x4 (&acc)[2][2][4][2], const Unit& u, int wr, int wc, int fr, int fq) const {
        const int row0 = u.pm * BM + wr * 64 + fr, col0 = (u.pn & 7) * BM + wc * 32 + 8 * fq;
#pragma unroll
        for (int ai = 0; ai < 2; ++ai)
#pragma unroll
            for (int m = 0; m < 4; ++m) { const int row = row0 + ai * HALF + m * 16; const float g = gate[row] * (1.f / W8_D); bf16_t* rowp = (bf16_t*)((char*)Y + (unsigned)(row * DM + col0) * 2u);
#pragma unroll
                for (int bj = 0; bj < 2; ++bj) { const f32x4 v0 = acc[ai][bj][m][0] * g, v1 = acc[ai][bj][m][1] * g;
                    u32x4 w; w.x = cvt_pk_bf16(v0[0], v0[1]); w.y = cvt_pk_bf16(v0[2], v0[3]); w.z = cvt_pk_bf16(v1[0], v1[1]); w.w = cvt_pk_bf16(v1[2], v1[3]);
                    *(u32x4*)(rowp + bj * HALF) = w; } }
    }
};

template <class Epi, class Sched, bool ALIGN_EPI = true, bool F8 = false, bool GATHER = false>
__device__ __forceinline__ void gemm_phase(LAS unsigned char* lds, const Gemm g, const Sched& S, const Epi& E) {
    const int tid = threadIdx.x, wid = __builtin_amdgcn_readfirstlane(tid >> 6), lane = tid & 63, wr = wid >> 2, wc = wid & 3, fr = lane & 15, fq = lane >> 4;
    const int K = g.K, nt = K / BK;
    unsigned voffA[2], voffB[2];
#pragma unroll
    for (int i = 0; i < 2; ++i) { int R, C; stage_rc(tid * 16 + i * 8192, R, C); const int Rb = Epi::PERM ? ((R & ~31) + perm32(R & 31)) : R;
        voffA[i] = (unsigned)(R * K + C) * 2u; voffB[i] = (unsigned)(Rb * K + C) * 2u; }
    const size_t kstep = (size_t)(BK * 2);
    const size_t hstep = (size_t)HALF * K * 2;
    const size_t tstep = 2 * hstep;
    const unsigned ldsw = (unsigned)wid * 1024u;
    const int aoff = lds_byte(wr * 64 + fr, fq * 8), boff = lds_byte(wc * 32 + fr, fq * 8);
#define PG8_SA(b, h) (((b) * 2 + (h)) * HTB)
#define PG8_SB(b, h) ((4 + (b) * 2 + (h)) * HTB)
#define PG8_STAGE(bufoff, gbase, voff) do { _Pragma("unroll") for (int _i = 0; _i < 2; ++_i) { \
        if constexpr (F8) { const unsigned long long gb_ = (unsigned long long)(uintptr_t)(gbase); const unsigned m0_ = (unsigned)(uintptr_t)(lds + (bufoff) + ldsw + _i * 8192); unsigned keep_; \
            asm volatile("s_mov_b32 %0, m0\n\ts_mov_b32 m0, %3\n\ts_nop 0\n\tglobal_load_lds_dwordx4 %1, %2\n\ts_mov_b32 m0, %0" : "=&s"(keep_) : "v"((voff)[_i]), "s"(gb_), "s"(m0_) : "memory"); } \
        else __builtin_amdgcn_global_load_lds((const unsigned*)((const char*)(gbase) + (voff)[_i]), (LAS unsigned*)(lds + (bufoff) + ldsw + _i * 8192), 16, 0, 0); } } while (0)
#define PG8_RD16(off) (*(const LAS u32x4*)(lds + (off)))
#define PG8_LDA(dst, b, h) do { if constexpr (F8) { _Pragma("unroll") for (int m = 0; m < 4; ++m) { const u32x4 lo_ = PG8_RD16(PG8_SA(b, h) + aoff + m * 2048), hi_ = PG8_RD16(PG8_SA(b, h) + aoff + m * 2048 + 1024); \
            dst##8[m] = (v8i_t){(int)lo_.x, (int)lo_.y, (int)lo_.z, (int)lo_.w, (int)hi_.x, (int)hi_.y, (int)hi_.z, (int)hi_.w}; } } \
        else { _Pragma("unroll") for (int m = 0; m < 4; ++m) _Pragma("unroll") for (int k = 0; k < 2; ++k) dst[m][k] = *(const LAS bf16x8*)(lds + PG8_SA(b, h) + aoff + m * 2048 + k * 1024); } } while (0)
#define PG8_LDB(dst, b, h) do { if constexpr (F8) { _Pragma("unroll") for (int n = 0; n < 2; ++n) { const u32x4 lo_ = PG8_RD16(PG8_SB(b, h) + boff + n * 2048), hi_ = PG8_RD16(PG8_SB(b, h) + boff + n * 2048 + 1024); \
            dst##8[n] = (v8i_t){(int)lo_.x, (int)lo_.y, (int)lo_.z, (int)lo_.w, (int)hi_.x, (int)hi_.y, (int)hi_.z, (int)hi_.w}; } } \
        else { _Pragma("unroll") for (int n = 0; n < 2; ++n) _Pragma("unroll") for (int k = 0; k < 2; ++k) dst[n][k] = *(const LAS bf16x8*)(lds + PG8_SB(b, h) + boff + n * 2048 + k * 1024); } } while (0)
#define PG8_MMA(ai, bj, At, Bt) do { __builtin_amdgcn_s_setprio(1); \
        if constexpr (F8) { _Pragma("unroll") for (int m = 0; m < 4; ++m) _Pragma("unroll") for (int n = 0; n < 2; ++n) \
            asm volatile("v_mfma_scale_f32_16x16x128_f8f6f4 %0, %1, %2, %0, %3, %3 op_sel_hi:[0,0,0]" : "+v"(acc[ai][bj][m][n]) : "v"(Bt##8[n]), "v"(At##8[m]), "v"(one8)); } \
        else { _Pragma("unroll") for (int m = 0; m < 4; ++m) _Pragma("unroll") for (int n = 0; n < 2; ++n) _Pragma("unroll") for (int k = 0; k < 2; ++k) \
            acc[ai][bj][m][n] = __builtin_amdgcn_mfma_f32_16x16x32_bf16(Bt[n][k], At[m][k], acc[ai][bj][m][n], 0, 0, 0); } \
        __builtin_amdgcn_s_setprio(0); } while (0)
#define PG8_WAIT_V(n) asm volatile("s_waitcnt vmcnt(" #n ")" ::: "memory")
#define PG8_WAIT_L(n) asm volatile("s_waitcnt lgkmcnt(" #n ")" ::: "memory")
#define PG8_BAR __builtin_amdgcn_s_barrier()
#define PG8_SCHED __builtin_amdgcn_sched_barrier(0)
    unsigned goffC[2][2] = {{0u, 0u}, {0u, 0u}}, goffN[2][2] = {{0u, 0u}, {0u, 0u}};
#define PG8_GOFF(dst, unit) do { _Pragma("unroll") for (int h_ = 0; h_ < 2; ++h_) _Pragma("unroll") for (int i_ = 0; i_ < 2; ++i_) { int R_, C_; stage_rc(tid * 16 + i_ * 8192, R_, C_); \
        dst[h_][i_] = (unsigned)g.idx[(unit).pm * BM + h_ * HALF + R_] * (unsigned)(K * 2) + (unsigned)(C_ * 2); } } while (0)
#define PG8_STAGEA(bufoff, ptr, h, nx) do { if constexpr (GATHER) { const unsigned gs_[2] = {(nx) ? goffN[h][0] : goffC[h][0], (nx) ? goffN[h][1] : goffC[h][1]}; PG8_STAGE(bufoff, ptr, gs_); } \
        else { PG8_STAGE(bufoff, (ptr) + (h) * hstep, voffA); } } while (0)
    Unit cur, nxt; int ui = 0;
    if (!S.next(0, cur)) return;
    f32x4 acc[2][2][4][2];
#pragma unroll
    for (int a = 0; a < 2; ++a)
#pragma unroll
        for (int b = 0; b < 2; ++b)
#pragma unroll
            for (int m = 0; m < 4; ++m)
#pragma unroll
                for (int n = 0; n < 2; ++n) acc[a][b][m][n] = (f32x4){0.f, 0.f, 0.f, 0.f};
    const int one8 = 0x7F7F7F7F;
    bf16x8 At[4][2], B0[2][2], B1[2][2]; v8i_t At8[4], B08[2], B18[2];
    const char* cA = GATHER ? (const char*)g.A : (const char*)g.A + (size_t)cur.pm * tstep; const char* cB = (const char*)g.Bt + (size_t)cur.pn * tstep;
    if constexpr (GATHER) PG8_GOFF(goffC, cur);
    S.a_ready(cur);
    PG8_STAGE(PG8_SB(0, 0), cB, voffB); PG8_STAGE(PG8_SB(0, 1), cB + hstep, voffB); PG8_STAGEA(PG8_SA(0, 0), cA, 0, false); PG8_STAGEA(PG8_SA(0, 1), cA, 1, false);
    if (wr == 1) PG8_BAR;
    PG8_WAIT_V(2); PG8_BAR;
    PG8_STAGE(PG8_SB(1, 0), cB + kstep, voffB); PG8_STAGEA(PG8_SA(1, 0), cA + kstep, 0, false); PG8_STAGE(PG8_SB(1, 1), cB + hstep + kstep, voffB);
    PG8_WAIT_V(6); PG8_BAR;
    for (;;) {
        const bool has_next = S.next(ui + 1, nxt);
        if constexpr (GATHER) { if (has_next) PG8_GOFF(goffN, nxt); else { goffN[0][0] = goffC[0][0]; goffN[0][1] = goffC[0][1]; goffN[1][0] = goffC[1][0]; goffN[1][1] = goffC[1][1]; } }
        const char* nA = GATHER ? (const char*)g.A : (has_next ? (const char*)g.A + (size_t)nxt.pm * tstep : cA); const char* nB = has_next ? (const char*)g.Bt + (size_t)nxt.pn * tstep : cB;
        for (int t = 0; t < nt; t += 2) {
            const bool last = (t == nt - 2);
            const char* a1 = cA + (size_t)(t + 1) * kstep;
            const char* a2 = last ? nA : cA + (size_t)(t + 2) * kstep; const char* b2 = last ? nB : cB + (size_t)(t + 2) * kstep;
            const char* a3 = a2 + kstep; const char* b3 = b2 + kstep;
            if (last && has_next) S.a_ready(nxt);
            PG8_LDB(B0, 0, 0); PG8_LDB(B1, 0, 1); PG8_SCHED; PG8_LDA(At, 0, 0); PG8_STAGEA(PG8_SA(1, 1), a1, 1, false);
            PG8_WAIT_V(8); PG8_WAIT_L(0); PG8_BAR; PG8_MMA(0, 0, At, B0); PG8_MMA(0, 1, At, B1); PG8_BAR; PG8_SCHED;
            PG8_LDA(At, 0, 1); PG8_STAGE(PG8_SB(0, 0), b2, voffB); PG8_STAGE(PG8_SB(0, 1), b2 + hstep, voffB); PG8_STAGEA(PG8_SA(0, 0), a2, 0, last);
            PG8_WAIT_V(8); PG8_WAIT_L(0); PG8_BAR; PG8_MMA(1, 0, At, B0); PG8_MMA(1, 1, At, B1); PG8_BAR; PG8_SCHED;
            PG8_LDB(B0, 1, 0); PG8_LDB(B1, 1, 1); PG8_SCHED; PG8_LDA(At, 1, 0); PG8_STAGEA(PG8_SA(0, 1), a2, 1, last);
            PG8_WAIT_V(8); PG8_WAIT_L(0); PG8_BAR; PG8_MMA(0, 0, At, B0); PG8_MMA(0, 1, At, B1); PG8_BAR; PG8_SCHED;
            PG8_LDA(At, 1, 1); PG8_STAGE(PG8_SB(1, 0), b3, voffB); PG8_STAGE(PG8_SB(1, 1), b3 + hstep, voffB); PG8_STAGEA(PG8_SA(1, 0), a3, 0, last);
            PG8_WAIT_V(8); PG8_WAIT_L(0); PG8_BAR; PG8_MMA(1, 0, At, B0); PG8_MMA(1, 1, At, B1); PG8_BAR; PG8_SCHED;
        }
        if constexpr (ALIGN_EPI) { if (wr == 0) PG8_BAR; }
        { int te_ = threadIdx.x; asm volatile("" : "+v"(te_));
          const int le_ = te_ & 63, we_ = __builtin_amdgcn_readfirstlane(te_ >> 6); E(acc, cur, we_ >> 2, we_ & 3, le_ & 15, le_ >> 4); } S.done(cur);
        if (!has_next) break;
#pragma unroll
        for (int a = 0; a < 2; ++a)
#pragma unroll
            for (int b = 0; b < 2; ++b)
#pragma unroll
                for (int m = 0; m < 4; ++m)
#pragma unroll
                    for (int n = 0; n < 2; ++n) acc[a][b][m][n] = (f32x4){0.f, 0.f, 0.f, 0.f};
        cur = nxt; cA = nA; cB = nB; ++ui;
        if constexpr (GATHER) { goffC[0][0] = goffN[0][0]; goffC[0][1] = goffN[0][1]; goffC[1][0] = goffN[1][0]; goffC[1][1] = goffN[1][1]; }
        if constexpr (ALIGN_EPI) { if (wr == 1) PG8_BAR; }
    }
    PG8_WAIT_V(0);
    if constexpr (!ALIGN_EPI) { if (wr == 0) PG8_BAR; }
    PG8_BAR;
#undef PG8_SA
#undef PG8_SB
#undef PG8_STAGE
#undef PG8_STAGEA
#undef PG8_GOFF
#undef PG8_LDA
#undef PG8_LDB
#undef PG8_MMA
#undef PG8_RD16
#undef PG8_WAIT_V
#undef PG8_WAIT_L
#undef PG8_BAR
#undef PG8_SCHED
}
}

__device__ __forceinline__ void glds16s(unsigned voff, const void* sbase, unsigned lds_dst) {
    unsigned keep; const unsigned long long sb = (unsigned long long)(uintptr_t)sbase;
    asm volatile("s_mov_b32 %0, m0\n\ts_mov_b32 m0, %3\n\ts_nop 0\n\tglobal_load_lds_dwordx4 %1, %2\n\ts_mov_b32 m0, %0" : "=&s"(keep) : "v"(voff), "s"(sb), "s"(lds_dst) : "memory");
}
__device__ __forceinline__ void glds16(const void* gsrc, unsigned lds_dst) {
    unsigned keep;
    asm volatile("s_mov_b32 %0, m0\n\ts_mov_b32 m0, %2\n\ts_nop 0\n\tglobal_load_lds_dwordx4 %1, off\n\ts_mov_b32 m0, %0" : "=&s"(keep) : "v"(gsrc), "s"(lds_dst) : "memory");
}
namespace att {
constexpr int NW = 8, QBLK = 32, KVBLK = 64;
constexpr float THR = 8.f;
constexpr int SHM_V = 16384, SHM_K = 16384, SHM_KR = 8192;
constexpr int OFF_V = 0, OFF_K = 2 * SHM_V, OFF_KR = OFF_K + 2 * SHM_K, OFF_WS = OFF_KR + 2 * SHM_KR, OFF_QR = OFF_WS + NW * 64 * 4, ATTN_LDS = OFF_QR + NW * 4096;
#define KSWZ(row, colB) ((row) * 256 + ((colB) ^ (((row) & 15) << 4)))
#define KSWZR(row, colB) ((row) * 256 + ((colB) ^ (((row) & 7) << 4)))
#define KRO(k, c) ((k) * 128 + ((((c) ^ ((k) >> 1)) & 7) << 4))
#define SBAR() __builtin_amdgcn_sched_barrier(0)
__device__ __forceinline__ int crow(int r, int hi) { return (r & 3) + 8 * (r >> 2) + 4 * hi; }
__device__ __forceinline__ bf16x8 ld8(const bf16_t* p) { return *reinterpret_cast<const bf16x8*>(p); }
template <int DQ> struct Sc { static constexpr float SCALE = DQ == 128 ? 0.08838834764831845f : 0.07216878364870322f; };

template <int DQ>
__device__ __forceinline__ void partialSM(f32x16& p0, f32x16& p1, float& m_reg, float& mn, float& alpha) {
  constexpr float SCALE = Sc<DQ>::SCALE, C = SCALE * 1.4426950408889634f;
  float pmax = p0[0];
#pragma unroll
  for (int r = 1; r < 16; ++r) pmax = fmaxf(pmax, p0[r]);
#pragma unroll
  for (int r = 0; r < 16; ++r) pmax = fmaxf(pmax, p1[r]);
  { auto rr = __builtin_amdgcn_permlane32_swap(__float_as_uint(pmax), __float_as_uint(pmax), false, false);
    pmax = fmaxf(__uint_as_float(rr[0]), __uint_as_float(rr[1])); }
  if (__builtin_expect(__all(pmax - m_reg <= THR / SCALE), 1)) { mn = m_reg; alpha = 1.f; }
  else { mn = fmaxf(m_reg, pmax); alpha = __builtin_amdgcn_exp2f((m_reg - mn) * C); m_reg = mn; }
  float mnC = -mn * C;
#pragma unroll
  for (int r = 0; r < 16; ++r) p0[r] = fmaf(p0[r], C, mnC);
#pragma unroll
  for (int r = 0; r < 16; ++r) p1[r] = fmaf(p1[r], C, mnC);
#pragma unroll
  for (int r = 0; r < 16; ++r) p0[r] = __builtin_amdgcn_exp2f(p0[r]);
}
__device__ __forceinline__ void finishSM(f32x16& p0, f32x16& p1, float alpha, float& l_reg, bf16x8& pa0, bf16x8& pa1, bf16x8& pa2, bf16x8& pa3) {
#pragma unroll
  for (int r = 0; r < 16; ++r) p1[r] = __builtin_amdgcn_exp2f(p1[r]);
  float ps = 0;
#pragma unroll
  for (int r = 0; r < 16; ++r) ps += p0[r];
#pragma unroll
  for (int r = 0; r < 16; ++r) ps += p1[r];
  { auto rr = __builtin_amdgcn_permlane32_swap(__float_as_uint(ps), __float_as_uint(ps), false, false);
    ps = __uint_as_float(rr[0]) + __uint_as_float(rr[1]); }
  l_reg = l_reg * alpha + ps;
#define PK4(P, BASE, OUT) do { unsigned a0 = cvt_pk_bf16(P[BASE + 0], P[BASE + 1]), a1 = cvt_pk_bf16(P[BASE + 2], P[BASE + 3]);   \
    unsigned b0 = cvt_pk_bf16(P[BASE + 4], P[BASE + 5]), b1 = cvt_pk_bf16(P[BASE + 6], P[BASE + 7]);                              \
    u32x4 w = {a0, a1, b0, b1}; OUT = *reinterpret_cast<bf16x8*>(&w); } while (0)
  PK4(p0, 0, pa0); PK4(p0, 8, pa1); PK4(p1, 0, pa2); PK4(p1, 8, pa3);
#undef PK4
}
template <int DQ>
__device__ __forceinline__ void qkt(f32x16& p0, f32x16& p1, const char* Ks, const char* KRs, const bf16x8* qr, const char* qrl, int r32, int hi) {
#pragma unroll
  for (int d0 = 0; d0 < 8; ++d0) { int cb = (d0 * 16 + hi * 8) * 2;
    bf16x8 b0 = *reinterpret_cast<const bf16x8*>(Ks + KSWZ(r32, cb));
    bf16x8 b1 = *reinterpret_cast<const bf16x8*>(Ks + KSWZ(32 + r32, cb));
    p0 = __builtin_amdgcn_mfma_f32_32x32x16_bf16(b0, qr[d0], p0, 0, 0, 0);
    p1 = __builtin_amdgcn_mfma_f32_32x32x16_bf16(b1, qr[d0], p1, 0, 0, 0); }
  if constexpr (DQ == 192) {
#pragma unroll
    for (int d0 = 0; d0 < 4; ++d0) { int cb = (d0 * 16 + hi * 8) * 2;
      bf16x8 b0 = *reinterpret_cast<const bf16x8*>(KRs + KSWZR(r32, cb));
      bf16x8 b1 = *reinterpret_cast<const bf16x8*>(KRs + KSWZR(r32, 128 + cb));
      bf16x8 q = *reinterpret_cast<const bf16x8*>(qrl + d0 * 1024);
      p0 = __builtin_amdgcn_mfma_f32_32x32x16_bf16(b0, q, p0, 0, 0, 0);
      p1 = __builtin_amdgcn_mfma_f32_32x32x16_bf16(b1, q, p1, 0, 0, 0); }
  }
}
__device__ __forceinline__ void alibi_init(f32x16& p0, f32x16& p1, float dq, float sig, int dw) {
  if (dw >= 63 || dw <= -31) {
    const float ss = dw >= 63 ? sig : -sig, base = -ss * dq;
#pragma unroll
    for (int r = 0; r < 16; ++r) { const float kr = (float)((r & 3) + 8 * (r >> 2)); p0[r] = fmaf(ss, kr, base); p1[r] = fmaf(ss, kr + 32.f, base); }
  } else {
#pragma unroll
    for (int r = 0; r < 16; ++r) { const float kr = (float)((r & 3) + 8 * (r >> 2)); p0[r] = -sig * fabsf(dq - kr); p1[r] = -sig * fabsf(dq - (kr + 32.f)); }
  }
}
__device__ __forceinline__ int v_st(int k, int c) { const int kk = (k & ~0xC) | ((k & 4) << 1) | ((k & 8) >> 1); return ((kk >> 3) * 4 + (c >> 5)) * 512 + ((kk & 7) * 32 + (c & 31)) * 2; }
__device__ __forceinline__ int v_rd_base(int lane) { return ((lane & 3) << 3) | (((lane >> 2) & 3) << 6) | (((lane >> 4) & 1) << 5) | (((lane >> 5) & 1) << 11); }
constexpr int v_rd_off(int d0, int ks, int half) { return d0 * 512 + ks * 4096 + half * 256; }
template <int OFF> __device__ __forceinline__ s16x4 tr_read(int vb) {
  s16x4 r; asm volatile("ds_read_b64_tr_b16 %0, %1 offset:%2" : "=&v"(r) : "v"(vb), "i"(OFF) : "memory"); return r;
}
template <int D0> __device__ __forceinline__ void pv_one(f32x16& od, int vb, bf16x8 pa0, bf16x8 pa1, bf16x8 pa2, bf16x8 pa3) {
  const s16x4 l0 = tr_read<v_rd_off(D0, 0, 0)>(vb), h0 = tr_read<v_rd_off(D0, 0, 1)>(vb), l1 = tr_read<v_rd_off(D0, 1, 0)>(vb), h1 = tr_read<v_rd_off(D0, 1, 1)>(vb);
  const s16x4 l2 = tr_read<v_rd_off(D0, 2, 0)>(vb), h2 = tr_read<v_rd_off(D0, 2, 1)>(vb), l3 = tr_read<v_rd_off(D0, 3, 0)>(vb), h3 = tr_read<v_rd_off(D0, 3, 1)>(vb);
  asm volatile("s_waitcnt lgkmcnt(0)" ::: "memory"); SBAR();
#define PK(L, H) (bf16x8){L[0], L[1], L[2], L[3], H[0], H[1], H[2], H[3]}
  od = __builtin_amdgcn_mfma_f32_32x32x16_bf16(pa0, PK(l0, h0), od, 0, 0, 0);
  od = __builtin_amdgcn_mfma_f32_32x32x16_bf16(pa1, PK(l1, h1), od, 0, 0, 0);
  od = __builtin_amdgcn_mfma_f32_32x32x16_bf16(pa2, PK(l2, h2), od, 0, 0, 0);
  od = __builtin_amdgcn_mfma_f32_32x32x16_bf16(pa3, PK(l3, h3), od, 0, 0, 0);
#undef PK
}
__device__ __forceinline__ void pv_d0(f32x16* o, int vb, bf16x8 pa0, bf16x8 pa1, bf16x8 pa2, bf16x8 pa3) {
  pv_one<0>(o[0], vb, pa0, pa1, pa2, pa3); pv_one<1>(o[1], vb, pa0, pa1, pa2, pa3); pv_one<2>(o[2], vb, pa0, pa1, pa2, pa3); pv_one<3>(o[3], vb, pa0, pa1, pa2, pa3);
}

template <int DQ, bool ALIBI, bool OBF, int LDQ, int LDK, int LDV, int LDO, int SDEPTH>
__device__ __forceinline__ void attn_body(const bf16_t* __restrict__ Qb, const bf16_t* __restrict__ Kh, const bf16_t* __restrict__ Vh, const bf16_t* __restrict__ KRh,
                                          void* __restrict__ Ob, int q0, int kt0, int NT, char* lds, float sig, const f32x2* csr, const f32x2* csc) {
  int tid = threadIdx.x; asm volatile("" : "+v"(tid));
  const int wid = __builtin_amdgcn_readfirstlane(tid >> 6), lane = tid & 63, r32 = lane & 31, hi = lane >> 5;
  char* V_lds = lds + OFF_V; char* K_lds = lds + OFF_K; char* KR_lds = lds + OFF_KR;
  float* ws = (float*)(lds + OFF_WS) + wid * 64; float* li_l = ws; float* al_l = ws + 32;
  float m_reg = -1e30f, l_reg = 0; f32x16 o[4] = {}; bf16x8 qr[8];
  char* qrl = lds + OFF_QR + wid * 4096 + lane * 16;
  const bf16_t* Qw = Qb + (long)(wid * QBLK + r32) * LDQ + hi * 8;
#pragma unroll
  for (int d0 = 0; d0 < 8; ++d0) qr[d0] = ld8(Qw + d0 * 16);
  if constexpr (DQ == 192) {
    const int tok = q0 + wid * QBLK + r32;
    const f32x2* tr = csr + (tok >> 6) * 16 + hi * 8; const f32x2* tc = csc + (tok & 63) * 16 + hi * 8;
    const bf16x8 a0 = ld8(Qw + 128), a1 = ld8(Qw + 144), b0 = ld8(Qw + 160), b1 = ld8(Qw + 176);
    unsigned wa[4], wb[4], wc_[4], wd[4];
#pragma unroll
    for (int e = 0; e < 8; e += 2) {
      const f32x2 c0 = tr[e], c1 = tr[e + 1], d0_ = tc[e], d1_ = tc[e + 1];
      const float x10 = bf2f((unsigned short)a0[e]), x11 = bf2f((unsigned short)a0[e + 1]), x20 = bf2f((unsigned short)a1[e]), x21 = bf2f((unsigned short)a1[e + 1]);
      wa[e >> 1] = cvt_pk_bf16(x10 * c0.x - x20 * c0.y, x11 * c1.x - x21 * c1.y);
      wb[e >> 1] = cvt_pk_bf16(x20 * c0.x + x10 * c0.y, x21 * c1.x + x11 * c1.y);
      const float y10 = bf2f((unsigned short)b0[e]), y11 = bf2f((unsigned short)b0[e + 1]), y20 = bf2f((unsigned short)b1[e]), y21 = bf2f((unsigned short)b1[e + 1]);
      wc_[e >> 1] = cvt_pk_bf16(y10 * d0_.x - y20 * d0_.y, y11 * d1_.x - y21 * d1_.y);
      wd[e >> 1] = cvt_pk_bf16(y20 * d0_.x + y10 * d0_.y, y21 * d1_.x + y11 * d1_.y);
    }
    *(u32x4*)(qrl) = (u32x4){wa[0], wa[1], wa[2], wa[3]};
    *(u32x4*)(qrl + 1024) = (u32x4){wb[0], wb[1], wb[2], wb[3]};
    *(u32x4*)(qrl + 2048) = (u32x4){wc_[0], wc_[1], wc_[2], wc_[3]};
    *(u32x4*)(qrl + 3072) = (u32x4){wd[0], wd[1], wd[2], wd[3]};
  }
  const int sr = tid >> 4, sc = (tid & 15) * 8, vst0 = v_st(sr, sc), vst1 = v_st(32 + sr, sc);
  const int krk = tid >> 3, krc = tid & 7, krst = KSWZR(krk & 31, (krk >> 5) * 128 + krc * 16);
  const int vb0 = (int)(uintptr_t)(LAS char*)V_lds + v_rd_base(lane);
  const int qw0 = q0 + wid * QBLK;
  const float dq0 = (float)(qw0 + r32 - 4 * hi);
  struct { bf16x8 vs0, vs1, ks0, ks1, kr; } sr_[SDEPTH];
  const unsigned voV0 = (unsigned)(sr * LDV + sc) * 2u, voV1 = voV0 + 32u * LDV * 2u, voK0 = (unsigned)(sr * LDK + sc) * 2u, voK1 = voK0 + 32u * LDK * 2u, voKR = (unsigned)(krk * 64 + krc * 8) * 2u;
#define SLOAD(i, k0) do { const char* Vt_ = (const char*)Vh + (size_t)(k0) * (LDV * 2); const char* Kt_ = (const char*)Kh + (size_t)(k0) * (LDK * 2); \
    sr_[i].vs0 = *(const bf16x8*)(Vt_ + voV0); sr_[i].vs1 = *(const bf16x8*)(Vt_ + voV1); \
    sr_[i].ks0 = *(const bf16x8*)(Kt_ + voK0); sr_[i].ks1 = *(const bf16x8*)(Kt_ + voK1); \
    if constexpr (DQ == 192) sr_[i].kr = *(const bf16x8*)((const char*)KRh + (size_t)(k0) * 128 + voKR); } while (0)
#define SWRITE(b, i) do { *(bf16x8*)(V_lds + (b) * SHM_V + vst0) = sr_[i].vs0;          \
    *(bf16x8*)(V_lds + (b) * SHM_V + vst1) = sr_[i].vs1; int kc = sc * 2;               \
    *(bf16x8*)(K_lds + (b) * SHM_K + KSWZ(sr, kc)) = sr_[i].ks0;                       \
    *(bf16x8*)(K_lds + (b) * SHM_K + KSWZ(32 + sr, kc)) = sr_[i].ks1;                  \
    if constexpr (DQ == 192) *(bf16x8*)(KR_lds + (b) * SHM_KR + krst) = sr_[i].kr; } while (0)
#define SWAIT() do { if constexpr (SDEPTH == 1) asm volatile("s_waitcnt vmcnt(0)" ::: "memory"); else if constexpr (DQ == 192) asm volatile("s_waitcnt vmcnt(5)" ::: "memory"); else asm volatile("s_waitcnt vmcnt(4)" ::: "memory"); } while (0)
#define RESC(a) do { if (__any((a) < 1.f)) { if (hi == 0) al_l[r32] = (a); asm volatile("s_waitcnt lgkmcnt(0)" ::: "memory"); \
    _Pragma("unroll") for (int d = 0; d < 4; ++d) _Pragma("unroll") for (int r = 0; r < 16; ++r) o[d][r] *= al_l[crow(r, hi)]; } } while (0)
#define PINIT(P0, P1, tj) do { if constexpr (ALIBI) { const int k0_ = (kt0 + (tj)) * KVBLK; alibi_init(P0, P1, dq0 - (float)k0_, sig, qw0 - k0_); } else { P0 = f32x16{}; P1 = f32x16{}; } } while (0)
  f32x16 pA0, pA1, pB0, pB1; float mnA, mnB, alA, alB; bf16x8 pa0, pa1, pa2, pa3;
  const int kb = kt0 * KVBLK;
  constexpr int SE = 0, SO = SDEPTH - 1;
  SLOAD(SE, kb); asm volatile("s_waitcnt vmcnt(0)" ::: "memory"); SWRITE(0, SE); __syncthreads();
  PINIT(pA0, pA1, 0); qkt<DQ>(pA0, pA1, K_lds, KR_lds, qr, qrl, r32, hi); partialSM<DQ>(pA0, pA1, m_reg, mnA, alA);
  SLOAD(SO, kb + KVBLK); if constexpr (SDEPTH == 2) { if (2 < NT) SLOAD(SE, kb + 2 * KVBLK); }
  SWAIT(); SWRITE(1, SO); __syncthreads();
  for (int j = 1; j + 1 < NT; j += 2) {
    SBAR(); PINIT(pB0, pB1, j); qkt<DQ>(pB0, pB1, K_lds + SHM_K, KR_lds + SHM_KR, qr, qrl, r32, hi);
    finishSM(pA0, pA1, alA, l_reg, pa0, pa1, pa2, pa3); SBAR();
    SLOAD(SO, kb + (j + SDEPTH) * KVBLK); SBAR();
    pv_d0(o, vb0, pa0, pa1, pa2, pa3); partialSM<DQ>(pB0, pB1, m_reg, mnB, alB);
    __syncthreads(); SWAIT(); SWRITE(0, SE);
    RESC(alB); __syncthreads();
    SBAR(); PINIT(pA0, pA1, j + 1); qkt<DQ>(pA0, pA1, K_lds, KR_lds, qr, qrl, r32, hi);
    finishSM(pB0, pB1, alB, l_reg, pa0, pa1, pa2, pa3); SBAR();
    if (SDEPTH == 1 || j + 3 < NT) SLOAD(SE, kb + (j + 1 + SDEPTH) * KVBLK); SBAR();
    pv_d0(o, vb0 + SHM_V, pa0, pa1, pa2, pa3); partialSM<DQ>(pA0, pA1, m_reg, mnA, alA);
    __syncthreads(); SWAIT(); SWRITE(1, SO);
    RESC(alA); __syncthreads();
  }
  SBAR(); PINIT(pB0, pB1, NT - 1); qkt<DQ>(pB0, pB1, K_lds + SHM_K, KR_lds + SHM_KR, qr, qrl, r32, hi);
  finishSM(pA0, pA1, alA, l_reg, pa0, pa1, pa2, pa3); SBAR();
  pv_d0(o, vb0, pa0, pa1, pa2, pa3); partialSM<DQ>(pB0, pB1, m_reg, mnB, alB);
  __syncthreads(); RESC(alB);
  finishSM(pB0, pB1, alB, l_reg, pa0, pa1, pa2, pa3); SBAR();
  pv_d0(o, vb0 + SHM_V, pa0, pa1, pa2, pa3);
  if (hi == 0) li_l[r32] = l_reg; asm volatile("s_waitcnt lgkmcnt(0)" ::: "memory");
  int lane_e = lane; asm volatile("" : "+v"(lane_e));
  const int r32e = lane_e & 31, hie = lane_e >> 5;
  float rli[16];
#pragma unroll
  for (int r = 0; r < 16; ++r) rli[r] = __builtin_amdgcn_rcpf(li_l[crow(r, hie)]);
  if constexpr (OBF) {
    bf16_t* Ow = (bf16_t*)Ob + (size_t)(wid * QBLK) * LDO + (unsigned)(4 * hie * LDO + r32e);
#pragma unroll
    for (int r = 0; r < 16; ++r) { const int orow = (r & 3) + 8 * (r >> 2);
#pragma unroll
      for (int d0 = 0; d0 < 4; ++d0) Ow[orow * LDO + d0 * 32] = (bf16_t)f2bf(o[d0][r] * rli[r]); }
  } else {
    float* Ow = (float*)Ob + (size_t)(wid * QBLK) * LDO + (unsigned)(4 * hie * LDO + r32e);
#pragma unroll
    for (int r = 0; r < 16; ++r) { const int orow = (r & 3) + 8 * (r >> 2);
#pragma unroll
      for (int d0 = 0; d0 < 4; ++d0) Ow[orow * LDO + d0 * 32] = o[d0][r] * rli[r]; }
  }
#undef SLOAD
#undef SWRITE
#undef SWAIT
#undef RESC
#undef PINIT
}
__device__ __forceinline__ unsigned cvt2(float lo, float hi) { typedef __bf16 b2_t __attribute__((ext_vector_type(2))); const f32x2 v = {lo, hi}; return __builtin_bit_cast(unsigned, __builtin_convertvector(v, b2_t)); }
template <int DQ>
__device__ __forceinline__ void partialSM_nb(f32x16& p0, f32x16& p1, float& m_reg, float& alpha) {
  constexpr float SCALE = Sc<DQ>::SCALE, C = SCALE * 1.4426950408889634f;
  float pmax = p0[0];
#pragma unroll
  for (int r = 1; r < 16; ++r) pmax = fmaxf(pmax, p0[r]);
#pragma unroll
  for (int r = 0; r < 16; ++r) pmax = fmaxf(pmax, p1[r]);
  { auto rr = __builtin_amdgcn_permlane32_swap(__float_as_uint(pmax), __float_as_uint(pmax), false, false);
    pmax = fmaxf(__uint_as_float(rr[0]), __uint_as_float(rr[1])); }
  const bool keep = __all(pmax - m_reg <= THR / SCALE);
  const float mn = keep ? m_reg : fmaxf(m_reg, pmax);
  alpha = __builtin_amdgcn_exp2f((m_reg - mn) * C);
  m_reg = mn;
  const float mnC = -mn * C;
#pragma unroll
  for (int r = 0; r < 16; ++r) p0[r] = fmaf(p0[r], C, mnC);
#pragma unroll
  for (int r = 0; r < 16; ++r) p1[r] = fmaf(p1[r], C, mnC);
#pragma unroll
  for (int r = 0; r < 16; ++r) p0[r] = __builtin_amdgcn_exp2f(p0[r]);
}
__device__ __forceinline__ void finishSM_nb(f32x16& p0, f32x16& p1, float alpha, float& l_reg, bf16x8& pa0, bf16x8& pa1, bf16x8& pa2, bf16x8& pa3) {
#pragma unroll
  for (int r = 0; r < 16; ++r) p1[r] = __builtin_amdgcn_exp2f(p1[r]);
  float ps = 0;
#pragma unroll
  for (int r = 0; r < 16; ++r) ps += p0[r];
#pragma unroll
  for (int r = 0; r < 16; ++r) ps += p1[r];
  { auto rr = __builtin_amdgcn_permlane32_swap(__float_as_uint(ps), __float_as_uint(ps), false, false);
    ps = __uint_as_float(rr[0]) + __uint_as_float(rr[1]); }
  l_reg = l_reg * alpha + ps;
#define PK4(P, BASE, OUT) do { unsigned a0 = cvt2(P[BASE + 0], P[BASE + 1]), a1 = cvt2(P[BASE + 2], P[BASE + 3]);   \
    unsigned b0 = cvt2(P[BASE + 4], P[BASE + 5]), b1 = cvt2(P[BASE + 6], P[BASE + 7]);                              \
    u32x4 w = {a0, a1, b0, b1}; OUT = *reinterpret_cast<bf16x8*>(&w); } while (0)
  PK4(p0, 0, pa0); PK4(p0, 8, pa1); PK4(p1, 0, pa2); PK4(p1, 8, pa3);
#undef PK4
}
#ifndef SGB_ON
#define SGB_ON 1
#endif
#define SGB(mask, n) do { if (SGB_ON) __builtin_amdgcn_sched_group_barrier(mask, n, 0); } while (0)
template <int DQ, int VPM>
__device__ __forceinline__ void qkt_pipe(f32x16& p0, f32x16& p1, const LAS char* kp, const LAS char* krp, const bf16x8* qr, const LAS char* qrl, int r32, int hi) {
#ifndef QK_AH
#define QK_AH 2
#endif
  constexpr int NP = DQ / 16, AH = QK_AH;
  bf16x8 fa[NP], fb[NP], fq[NP > 8 ? NP - 8 : 1];
#define RD_PAIR(i) do { if ((i) < 8) { const int a_ = KSWZ(r32, ((i) * 16 + hi * 8) * 2); fa[i] = *(const LAS bf16x8*)(kp + a_); fb[i] = *(const LAS bf16x8*)(kp + a_ + 8192); } \
    else { const int a_ = KRO(r32, 2 * ((i) - 8) + hi); fa[i] = *(const LAS bf16x8*)(krp + a_); fb[i] = *(const LAS bf16x8*)(krp + a_ + 4096); fq[(i) < 8 ? 0 : (i) - 8] = *(const LAS bf16x8*)(qrl + ((i) - 8) * 1024); } } while (0)
#pragma unroll
  for (int i = 0; i < AH; ++i) RD_PAIR(i);
  SGB(0x100, 2 * AH);
#pragma unroll
  for (int i = 0; i < NP; ++i) {
    const bf16x8 q = i < 8 ? qr[i < 8 ? i : 0] : fq[i < 8 ? 0 : i - 8];
    p0 = __builtin_amdgcn_mfma_f32_32x32x16_bf16(fa[i], q, p0, 0, 0, 0); SGB(0x008, 1); SGB(0x002, VPM);
    if (i + AH < NP) { RD_PAIR(i + AH); if (i + AH < 8) SGB(0x100, 2); else SGB(0x100, 3); }
    p1 = __builtin_amdgcn_mfma_f32_32x32x16_bf16(fb[i], q, p1, 0, 0, 0); SGB(0x008, 1); SGB(0x002, VPM);
  }
#undef RD_PAIR
}
template <int VPM>
__device__ __forceinline__ void pv_pipe(f32x16* o, int vb, bf16x8 pa0, bf16x8 pa1, bf16x8 pa2, bf16x8 pa3) {
#define TR(off) __builtin_amdgcn_ds_read_tr16_b64_v4i16((LAS s16x4*)(uintptr_t)(unsigned)(vb + (off)))
#define PK(L, H) (bf16x8){L[0], L[1], L[2], L[3], H[0], H[1], H[2], H[3]}
  s16x4 lo[4][4], hh[4][4];
#pragma unroll
  for (int k = 0; k < 4; ++k) { lo[0][k] = TR(v_rd_off(0, k, 0)); hh[0][k] = TR(v_rd_off(0, k, 1)); }
  SGB(0x100, 8);
  const bf16x8 pa[4] = {pa0, pa1, pa2, pa3};
#pragma unroll
  for (int d0 = 0; d0 < 4; ++d0)
#pragma unroll
    for (int k = 0; k < 4; ++k) {
      o[d0] = __builtin_amdgcn_mfma_f32_32x32x16_bf16(pa[k], PK(lo[d0][k], hh[d0][k]), o[d0], 0, 0, 0); SGB(0x008, 1); SGB(0x002, VPM);
      if (d0 < 3) { lo[d0 + 1][k] = TR(v_rd_off(d0 + 1, k, 0)); hh[d0 + 1][k] = TR(v_rd_off(d0 + 1, k, 1)); SGB(0x100, 2); }
    }
#undef TR
#undef PK
}

__device__ __forceinline__ float vmax3(float a, float b, float c) { float r; asm("v_max3_f32 %0, %1, %2, %3" : "=v"(r) : "v"(a), "v"(b), "v"(c)); return r; }
__device__ __forceinline__ float vmax2(float a, float b) { float r; asm("v_max_f32 %0, %1, %2" : "=v"(r) : "v"(a), "v"(b)); return r; }
__device__ __forceinline__ bf16x8 scale_frag(bf16x8 v, float c) {
  u32x4 w;
  w.x = cvt2(bf2f((unsigned short)v[0]) * c, bf2f((unsigned short)v[1]) * c); w.y = cvt2(bf2f((unsigned short)v[2]) * c, bf2f((unsigned short)v[3]) * c);
  w.z = cvt2(bf2f((unsigned short)v[4]) * c, bf2f((unsigned short)v[5]) * c); w.w = cvt2(bf2f((unsigned short)v[6]) * c, bf2f((unsigned short)v[7]) * c);
  return *reinterpret_cast<bf16x8*>(&w);
}
__device__ __forceinline__ void finishSM_noexp(const f32x16& p0, const f32x16& p1, float& l_reg, bf16x8& pa0, bf16x8& pa1, bf16x8& pa2, bf16x8& pa3) {
  float s0 = 0.f, s1 = 0.f, s2 = 0.f, s3 = 0.f;
#pragma unroll
  for (int r = 0; r < 16; r += 2) { s0 += p0[r]; s1 += p0[r + 1]; s2 += p1[r]; s3 += p1[r + 1]; }
  float ps = (s0 + s1) + (s2 + s3);
  { auto rr = __builtin_amdgcn_permlane32_swap(__float_as_uint(ps), __float_as_uint(ps), false, false); ps = __uint_as_float(rr[0]) + __uint_as_float(rr[1]); }
  l_reg += ps;
#define PK4(P, BASE, OUT) do { unsigned a0 = cvt2(P[BASE + 0], P[BASE + 1]), a1 = cvt2(P[BASE + 2], P[BASE + 3]), b0 = cvt2(P[BASE + 4], P[BASE + 5]), b1 = cvt2(P[BASE + 6], P[BASE + 7]); \
    u32x4 w = {a0, a1, b0, b1}; OUT = *reinterpret_cast<bf16x8*>(&w); } while (0)
  PK4(p0, 0, pa0); PK4(p0, 8, pa1); PK4(p1, 0, pa2); PK4(p1, 8, pa3);
#undef PK4
}
struct FinState { float ps0, ps1; unsigned c[16]; };
#ifndef PROBE_GQA
#define PROBE_GQA 0
#endif
template <int W, int PRB, bool FIX>
__device__ __forceinline__ void fin_slot(f32x16& p0, f32x16& p1, FinState& st, bf16x8& pa0, bf16x8& pa1, bf16x8& pa2, bf16x8& pa3) {
  if constexpr (!(PRB & 1) && !FIX) p1[W] = __builtin_amdgcn_exp2f(p1[W]);
  st.ps0 += p0[W]; st.ps1 += p1[W];
  if constexpr (W < 8) st.c[W] = cvt2(p0[2 * W], p0[2 * W + 1]); else st.c[W] = cvt2(p1[2 * (W - 8)], p1[2 * (W - 8) + 1]);
  if constexpr ((W & 3) == 3) { constexpr int m = W >> 2;
    u32x4 w;
    w = (u32x4){st.c[4 * m], st.c[4 * m + 1], st.c[4 * m + 2], st.c[4 * m + 3]}; const bf16x8 v = *reinterpret_cast<bf16x8*>(&w);
    if constexpr (m == 0) pa0 = v; else if constexpr (m == 1) pa1 = v; else if constexpr (m == 2) pa2 = v; else pa3 = v; }
}
template <int DQ, int PRB, bool FIX, int KOFF, int KROFF = 0>
__device__ __forceinline__ void region1(f32x16& p0, f32x16& p1, const int kro, const int krro, const bf16x8* qr, const LAS char* qrl, int* ka, int r32, int hi,
                                        f32x16& q0_, f32x16& q1_, float alpha, float& l_reg, bf16x8& pa0, bf16x8& pa1, bf16x8& pa2, bf16x8& pa3) {
  constexpr int NP = DQ / 16, AH = 2;
  bf16x8 fa[NP], fb[NP], fq[NP > 8 ? NP - 8 : 1];
  FinState st; st.ps0 = 0.f; st.ps1 = 0.f;
#pragma unroll
  for (int i = 0; i < (DQ == 192 ? 12 : 8); ++i) asm volatile("" : "+v"(ka[i]));
#define KLD(addr) (*(const LAS bf16x8*)(uintptr_t)(unsigned)(addr))
#define RD_PAIR(i) do { if ((PRB & 4) && (i) > 0) { fa[i] = fa[0]; fb[i] = fb[0]; } else if ((i) < 8) { const int a_ = ka[(i) < 8 ? (i) : 0] + kro; fa[i] = KLD(a_ + KOFF); fb[i] = KLD(a_ + (KOFF + 8192)); } \
    else { const int a_ = ka[(i) >= 8 ? (i) : 8] + krro; fa[i] = KLD(a_ + KROFF); fb[i] = KLD(a_ + (KROFF + 4096)); fq[(i) < 8 ? 0 : (i) - 8] = *(const LAS bf16x8*)(qrl + ((i) - 8) * 1024); } } while (0)
#define FIN(slot) do { constexpr int s_ = (slot); if constexpr (PRB & (2 | 16)) {} else if constexpr (NP == 8) fin_slot<s_, PRB, FIX>(q0_, q1_, st, pa0, pa1, pa2, pa3); \
    else if constexpr (s_ % 3 != 2) fin_slot<s_ - s_ / 3, PRB, FIX>(q0_, q1_, st, pa0, pa1, pa2, pa3); } while (0)
#pragma unroll
  for (int i = 0; i < AH; ++i) RD_PAIR(i);
  SBAR();
#define R1_PAIR(i) do { const bf16x8 q = (i) < 8 ? qr[(i) < 8 ? (i) : 0] : fq[(i) < 8 ? 0 : (i) - 8]; \
    if constexpr (!(PRB & 8)) p0 = __builtin_amdgcn_mfma_f32_32x32x16_bf16(fa[i], q, p0, 0, 0, 0); else p0[i] += __builtin_bit_cast(float, fa[i][0] | (q[0] << 16)); FIN(2 * (i)); if ((i) + AH < NP) RD_PAIR((i) + AH); SBAR(); \
    if constexpr (!(PRB & 8)) p1 = __builtin_amdgcn_mfma_f32_32x32x16_bf16(fb[i], q, p1, 0, 0, 0); else p1[i] += __builtin_bit_cast(float, fb[i][0] | (q[1] << 16)); FIN(2 * (i) + 1); SBAR(); } while (0)
  R1_PAIR(0); R1_PAIR(1); R1_PAIR(2); R1_PAIR(3); R1_PAIR(4); R1_PAIR(5); R1_PAIR(6); R1_PAIR(7);
  if constexpr (NP == 12) { R1_PAIR(8); R1_PAIR(9); R1_PAIR(10); R1_PAIR(11); }
#undef R1_PAIR
#undef FIN
#undef RD_PAIR
#undef KLD
  float ps = st.ps0 + st.ps1;
  { auto rr = __builtin_amdgcn_permlane32_swap(__float_as_uint(ps), __float_as_uint(ps), false, false);
    ps = __uint_as_float(rr[0]) + __uint_as_float(rr[1]); }
  l_reg = l_reg * alpha + ps;
}
template <int DQ, int PRB, bool FIX>
__device__ __forceinline__ void region2(f32x16* o, int vb, bf16x8 pa0, bf16x8 pa1, bf16x8 pa2, bf16x8 pa3, f32x16& p0, f32x16& p1, float& m_reg, float& alpha) {
  constexpr float SCALE = Sc<DQ>::SCALE, C = SCALE * 1.4426950408889634f;
#define TR(off) __builtin_amdgcn_ds_read_tr16_b64_v4i16((LAS s16x4*)(uintptr_t)(unsigned)(vb + (off)))
#define PK(L, H) (bf16x8){L[0], L[1], L[2], L[3], H[0], H[1], H[2], H[3]}
  s16x4 lo[4][4], hh[4][4];
#pragma unroll
  for (int k = 0; k < 4; ++k) { lo[0][k] = TR(v_rd_off(0, k, 0)); hh[0][k] = TR(v_rd_off(0, k, 1)); }
  SBAR();
  const bf16x8 pa[4] = {pa0, pa1, pa2, pa3};
  float t0, t1, t2, t3, mnC = 0.f;
#define PEXP(x) ((PRB & 1) ? (x) : __builtin_amdgcn_exp2f(x))
#define SM_SLOT(sl) do { constexpr int s_ = (sl); if constexpr (PRB & (2 | 32)) {} else if constexpr (FIX) { p0[s_] = __builtin_amdgcn_exp2f(p0[s_]); p1[s_] = __builtin_amdgcn_exp2f(p1[s_]); if constexpr (s_ == 0) alpha = 1.f; } else { \
    if constexpr (s_ == 0) { t0 = vmax2(vmax3(vmax3(vmax3(p0[0], p0[1], p0[2]), p0[3], p0[4]), p0[5], p0[6]), p0[7]); } \
    if constexpr (s_ == 1) { t1 = vmax2(vmax3(vmax3(vmax3(p0[8], p0[9], p0[10]), p0[11], p0[12]), p0[13], p0[14]), p0[15]); } \
    if constexpr (s_ == 2) { t2 = vmax2(vmax3(vmax3(vmax3(p1[0], p1[1], p1[2]), p1[3], p1[4]), p1[5], p1[6]), p1[7]); } \
    if constexpr (s_ == 3) { t3 = vmax2(vmax3(vmax3(vmax3(p1[8], p1[9], p1[10]), p1[11], p1[12]), p1[13], p1[14]), p1[15]); } \
    if constexpr (s_ == 4) { float pmax = vmax2(vmax3(t0, t1, t2), t3); \
        if constexpr (!(PRB & 64)) { auto rr = __builtin_amdgcn_permlane32_swap(__float_as_uint(pmax), __float_as_uint(pmax), false, false); pmax = vmax2(__uint_as_float(rr[0]), __uint_as_float(rr[1])); } \
        const bool keep = (PRB & 128) ? true : __all(pmax - m_reg <= THR / SCALE); const float mn = keep ? m_reg : vmax2(m_reg, pmax); \
        alpha = PEXP((m_reg - mn) * C); m_reg = mn; mnC = -mn * C; } \
    if constexpr (s_ >= 5) { constexpr int k_ = s_ - 5; \
        _Pragma("unroll") for (int e_ = 3 * k_; e_ < 3 * k_ + 3; ++e_) { if (e_ < 16) p0[e_ < 16 ? e_ : 0] = fmaf(p0[e_ < 16 ? e_ : 0], C, mnC); else if (e_ < 32) p1[(e_ >= 16 && e_ < 32) ? e_ - 16 : 0] = fmaf(p1[(e_ >= 16 && e_ < 32) ? e_ - 16 : 0], C, mnC); } \
        if constexpr (k_ >= 1 && k_ <= 8) { p0[2 * (k_ - 1)] = PEXP(p0[2 * (k_ - 1)]); p0[2 * (k_ - 1) + 1] = PEXP(p0[2 * (k_ - 1) + 1]); } } } } while (0)
#define R2_SLOT(d0, k) do { if constexpr (!(PRB & 8)) o[d0] = __builtin_amdgcn_mfma_f32_32x32x16_bf16(pa[k], PK(lo[d0][k], hh[d0][k]), o[d0], 0, 0, 0); else o[d0][k] += __builtin_bit_cast(float, (int)lo[d0][k][0] | ((int)hh[d0][k][1] << 16)) + __builtin_bit_cast(float, (int)pa[k][0]); SM_SLOT(4 * (d0) + (k)); \
    if ((d0) < 3) { if constexpr (PRB & 4) { lo[(d0) < 3 ? (d0) + 1 : 0][k] = lo[0][k]; hh[(d0) < 3 ? (d0) + 1 : 0][k] = hh[0][k]; } else { lo[(d0) < 3 ? (d0) + 1 : 0][k] = TR(v_rd_off((d0) + 1, k, 0)); hh[(d0) < 3 ? (d0) + 1 : 0][k] = TR(v_rd_off((d0) + 1, k, 1)); } } SBAR(); } while (0)
  R2_SLOT(0, 0); R2_SLOT(0, 1); R2_SLOT(0, 2); R2_SLOT(0, 3);
  R2_SLOT(1, 0); R2_SLOT(1, 1); R2_SLOT(1, 2); R2_SLOT(1, 3);
  R2_SLOT(2, 0); R2_SLOT(2, 1); R2_SLOT(2, 2); R2_SLOT(2, 3);
  R2_SLOT(3, 0); R2_SLOT(3, 1); R2_SLOT(3, 2); R2_SLOT(3, 3);
#undef R2_SLOT
#undef SM_SLOT
#undef PEXP
#undef TR
#undef PK
}

#ifndef RING4
#define RING4 1
#endif
template <int DQ> struct RingGeo { static constexpr int NSLOT = (DQ == 128 && RING4) ? 4 : 3, R_K = 0, R_KR = 49152, R_V = DQ == 192 ? 73728 : NSLOT * 16384, OFF_WS2 = R_V + NSLOT * 16384, OFF_QR2 = OFF_WS2 + 2048, BYTES = OFF_QR2 + (DQ == 192 ? NW * 4096 : 0); };
template <int DQ, bool ALIBI, bool OBF, int LDQ, int LDK, int LDV, int LDO, bool FIX>
__device__ __forceinline__ void attn_ring(const bf16_t* __restrict__ Qb, const bf16_t* __restrict__ Kh, const bf16_t* __restrict__ Vh, const bf16_t* __restrict__ KRh,
                                          void* __restrict__ Ob, int q0, int kt0, int NT, char* lds, float sig, const f32x2* csr, const f32x2* csc, unsigned* flag) {
  using RG = RingGeo<DQ>;
  constexpr int R_V = RG::R_V, R_K = RG::R_K, R_KR = RG::R_KR;
  int tid = threadIdx.x; asm volatile("" : "+v"(tid));
  const int wid = __builtin_amdgcn_readfirstlane(tid >> 6), lane = tid & 63, r32 = lane & 31, hi = lane >> 5;
  LAS char* ldsl = (LAS char*)lds;
  float* ws = (float*)(lds + RG::OFF_WS2) + wid * 64; float* li_l = ws; float* al_l = ws + 32;
  unsigned voK[2], voV[2], voKR;
#pragma unroll
  for (int i = 0; i < 2; ++i) { const int q = wid * 2 + i;
    { const int row = q * 4 + (lane >> 4), c = (lane & 15) ^ (row & 15); voK[i] = (unsigned)(row * LDK + c * 8) * 2u; }
    { const int st = q * 2 + (lane >> 5), w = lane & 31, kk = (st >> 2) * 8 + (w >> 2), c = (st & 3) * 32 + (w & 3) * 8, k = (kk & ~0xC) | ((kk & 4) << 1) | ((kk & 8) >> 1);
      voV[i] = (unsigned)(k * LDV + c) * 2u; } }
  { const int key = wid * 8 + (lane >> 3), ch = ((lane & 7) ^ (key >> 1)) & 7; voKR = (unsigned)(key * 64 + ch * 8) * 2u; }
#define DMA(buf, tile) do { const size_t k0_ = (size_t)(kt0 + (tile)) * KVBLK; const char* Vt_ = (const char*)Vh + k0_ * (LDV * 2); const char* Kt_ = (const char*)Kh + k0_ * (LDK * 2); \
    LAS char* sl_ = ldsl + (buf) + wid * 2048; \
    glds16s(voV[0], Vt_, (unsigned)(uintptr_t)(LAS char*)(sl_ + R_V)); \
    glds16s(voV[1], Vt_, (unsigned)(uintptr_t)(LAS char*)(sl_ + R_V + 1024)); \
    glds16s(voK[0], Kt_, (unsigned)(uintptr_t)(LAS char*)(sl_ + R_K)); \
    glds16s(voK[1], Kt_, (unsigned)(uintptr_t)(LAS char*)(sl_ + R_K + 1024)); \
    if constexpr (DQ == 192) glds16s(voKR, (const char*)KRh + k0_ * 128, (unsigned)(uintptr_t)(LAS char*)(ldsl + R_KR + ((buf) >> 1) + wid * 1024)); } while (0)
  DMA(0, 0); DMA(16384, 1);
  if constexpr (RG::NSLOT == 4) { if (2 < NT) DMA(32768, 2); }
  float m_reg = -1e30f, l_reg = 0; f32x16 o[4] = {}; bf16x8 qr[8];
  char* qrl = lds + RG::OFF_QR2 + wid * 4096 + lane * 16;
  const bf16_t* Qw = Qb + (long)(wid * QBLK + r32) * LDQ + hi * 8;
  constexpr float QC = FIX ? Sc<DQ>::SCALE * 1.4426950408889634f : 1.f;
#pragma unroll
  for (int d0 = 0; d0 < 8; ++d0) { qr[d0] = ld8(Qw + d0 * 16); if constexpr (FIX) qr[d0] = scale_frag(qr[d0], QC); }
  if constexpr (DQ == 192) {
    const int tok = q0 + wid * QBLK + r32;
    const f32x2* tr = csr + (tok >> 6) * 16 + hi * 8; const f32x2* tc = csc + (tok & 63) * 16 + hi * 8;
    const bf16x8 a0 = ld8(Qw + 128), a1 = ld8(Qw + 144), b0 = ld8(Qw + 160), b1 = ld8(Qw + 176);
    unsigned wa[4], wb[4], wc_[4], wd[4];
#pragma unroll
    for (int e = 0; e < 8; e += 2) {
      const f32x2 c0 = tr[e] * QC, c1 = tr[e + 1] * QC, d0_ = tc[e] * QC, d1_ = tc[e + 1] * QC;
      const float x10 = bf2f((unsigned short)a0[e]), x11 = bf2f((unsigned short)a0[e + 1]), x20 = bf2f((unsigned short)a1[e]), x21 = bf2f((unsigned short)a1[e + 1]);
      wa[e >> 1] = cvt_pk_bf16(x10 * c0.x - x20 * c0.y, x11 * c1.x - x21 * c1.y);
      wb[e >> 1] = cvt_pk_bf16(x20 * c0.x + x10 * c0.y, x21 * c1.x + x11 * c1.y);
      const float y10 = bf2f((unsigned short)b0[e]), y11 = bf2f((unsigned short)b0[e + 1]), y20 = bf2f((unsigned short)b1[e]), y21 = bf2f((unsigned short)b1[e + 1]);
      wc_[e >> 1] = cvt_pk_bf16(y10 * d0_.x - y20 * d0_.y, y11 * d1_.x - y21 * d1_.y);
      wd[e >> 1] = cvt_pk_bf16(y20 * d0_.x + y10 * d0_.y, y21 * d1_.x + y11 * d1_.y);
    }
    *(u32x4*)(qrl) = (u32x4){wa[0], wa[1], wa[2], wa[3]};
    *(u32x4*)(qrl + 1024) = (u32x4){wb[0], wb[1], wb[2], wb[3]};
    *(u32x4*)(qrl + 2048) = (u32x4){wc_[0], wc_[1], wc_[2], wc_[3]};
    *(u32x4*)(qrl + 3072) = (u32x4){wd[0], wd[1], wd[2], wd[3]};
  }
  int ka[12];
#pragma unroll
  for (int i = 0; i < 8; ++i) { ka[i] = (int)(uintptr_t)ldsl + KSWZ(r32, (i * 16 + hi * 8) * 2); asm volatile("" : "+v"(ka[i])); }
#pragma unroll
  for (int i = 8; i < 12; ++i) { ka[i] = 0; if constexpr (DQ == 192) { ka[i] = (int)(uintptr_t)ldsl + 32768 + KRO(r32, 2 * (i - 8) + hi); asm volatile("" : "+v"(ka[i])); } }
  int vb0 = (int)(uintptr_t)ldsl + R_V + v_rd_base(lane); asm volatile("" : "+v"(vb0));
  const int qw0 = q0 + wid * QBLK;
  const float dq0 = (float)(qw0 + r32 - 4 * hi);
#define RESC(a) do { if (__any((a) < 1.f)) { if (hi == 0) al_l[r32] = (a); asm volatile("s_waitcnt lgkmcnt(0)" ::: "memory"); \
    _Pragma("unroll") for (int d = 0; d < 4; ++d) _Pragma("unroll") for (int r = 0; r < 16; ++r) o[d][r] *= al_l[crow(r, hi)]; } } while (0)
#define PINIT(P0, P1, tj) do { if constexpr (ALIBI) { const int k0_ = (kt0 + (tj)) * KVBLK; alibi_init(P0, P1, dq0 - (float)k0_, sig, qw0 - k0_); } else { P0 = f32x16{}; P1 = f32x16{}; } } while (0)
#define STEP(PC0, PC1, MNC, ALC, PP0, PP1, ALP, tj) do { \
    if constexpr (NSLOT == 4) { if ((tj) + 1 < NT) asm volatile("s_waitcnt vmcnt(4)" ::: "memory"); else asm volatile("s_waitcnt vmcnt(0)" ::: "memory"); } \
    else asm volatile("s_waitcnt vmcnt(0)" ::: "memory"); \
    __builtin_amdgcn_s_barrier(); \
    if constexpr (NSLOT == 4) { if ((tj) + 2 < NT) DMA(on2, (tj) + 2); } else { if ((tj) + 1 < NT) DMA(on, (tj) + 1); } \
    PINIT(PC0, PC1, tj); SBAR(); \
    region1<DQ, PRBV, FIX, 0>(PC0, PC1, R_K + oc, R_KR + (oc >> 1) - 32768, qr, (const LAS char*)qrl, ka, r32, hi, PP0, PP1, ALP, l_reg, pa0, pa1, pa2, pa3); SBAR(); \
    region2<DQ, PRBV, FIX>(o, vb0 + op, pa0, pa1, pa2, pa3, PC0, PC1, m_reg, ALC); SBAR(); \
    if constexpr (!FIX) RESC(ALC); { const int t_ = op; op = oc; oc = on; if constexpr (NSLOT == 4) { on = on2; on2 = t_; } else on = t_; } } while (0)
  constexpr int NSLOT = RG::NSLOT;
  constexpr int PRBV = (!ALIBI && DQ == 128) ? PROBE_GQA : 0;
  if (wid >= 4) __builtin_amdgcn_s_setprio(1);
  f32x16 pA0, pA1, pB0, pB1; float mnA, mnB, alA, alB; bf16x8 pa0, pa1, pa2, pa3;
  int op = 0, oc = 16384, on = 32768, on2 = 49152;
  asm volatile("s_waitcnt vmcnt(0)" ::: "memory");
  __builtin_amdgcn_s_barrier();
  PINIT(pA0, pA1, 0); qkt_pipe<DQ, 0>(pA0, pA1, ldsl + R_K, ldsl + R_KR, qr, (const LAS char*)qrl, r32, hi); if constexpr (FIX) { _Pragma("unroll") for (int r = 0; r < 16; ++r) { pA0[r] = __builtin_amdgcn_exp2f(pA0[r]); pA1[r] = __builtin_amdgcn_exp2f(pA1[r]); } alA = 1.f; } else partialSM_nb<DQ>(pA0, pA1, m_reg, alA);
  if constexpr (NSLOT == 4) {
#define STEP4(PC0, PC1, ALC, PP0, PP1, ALP, SC, SP, SN2, tj) do { \
    if ((tj) + 1 < NT) asm volatile("s_waitcnt vmcnt(4)" ::: "memory"); else asm volatile("s_waitcnt vmcnt(0)" ::: "memory"); \
    __builtin_amdgcn_s_barrier(); \
    if ((tj) + 2 < NT) DMA((SN2) * 16384, (tj) + 2); \
    PINIT(PC0, PC1, tj); SBAR(); \
    region1<DQ, PRBV, FIX, R_K + (SC) * 16384, R_KR>(PC0, PC1, 0, 0, qr, (const LAS char*)qrl, ka, r32, hi, PP0, PP1, ALP, l_reg, pa0, pa1, pa2, pa3); SBAR(); \
    { int vb_ = vb0; asm volatile("" : "+v"(vb_)); region2<DQ, PRBV, FIX>(o, vb_ + (SP) * 16384, pa0, pa1, pa2, pa3, PC0, PC1, m_reg, ALC); } SBAR(); \
    if constexpr (!FIX) RESC(ALC); } while (0)
    STEP4(pB0, pB1, alB, pA0, pA1, alA, 1, 0, 3, 1);
    STEP4(pA0, pA1, alA, pB0, pB1, alB, 2, 1, 0, 2);
    STEP4(pB0, pB1, alB, pA0, pA1, alA, 3, 2, 1, 3);
    for (int j = 4; j < NT; j += 4) {
      STEP4(pA0, pA1, alA, pB0, pB1, alB, 0, 3, 2, j);
      STEP4(pB0, pB1, alB, pA0, pA1, alA, 1, 0, 3, j + 1);
      STEP4(pA0, pA1, alA, pB0, pB1, alB, 2, 1, 0, j + 2);
      STEP4(pB0, pB1, alB, pA0, pA1, alA, 3, 2, 1, j + 3);
    }
#undef STEP4
    if constexpr (FIX) finishSM_noexp(pB0, pB1, l_reg, pa0, pa1, pa2, pa3); else finishSM_nb(pB0, pB1, alB, l_reg, pa0, pa1, pa2, pa3); SBAR();
    pv_pipe<0>(o, vb0 + 3 * 16384, pa0, pa1, pa2, pa3);
  } else if (NT % 6 == 4) {
#define STEP3(PC0, PC1, ALC, PP0, PP1, ALP, SC, SP, SN, tj) do { \
    asm volatile("s_waitcnt vmcnt(0)" ::: "memory"); __builtin_amdgcn_s_barrier(); \
    if ((tj) + 1 < NT) DMA((SN) * 16384, (tj) + 1); \
    PINIT(PC0, PC1, tj); SBAR(); \
    region1<DQ, PRBV, FIX, R_K + (SC) * 16384, R_KR + (SC) * 8192 - 32768>(PC0, PC1, 0, 0, qr, (const LAS char*)qrl, ka, r32, hi, PP0, PP1, ALP, l_reg, pa0, pa1, pa2, pa3); SBAR(); \
    { int vb_ = vb0; asm volatile("" : "+v"(vb_)); region2<DQ, PRBV, FIX>(o, vb_ + (SP) * 16384, pa0, pa1, pa2, pa3, PC0, PC1, m_reg, ALC); } SBAR(); \
    if constexpr (!FIX) RESC(ALC); } while (0)
    STEP3(pB0, pB1, alB, pA0, pA1, alA, 1, 0, 2, 1);
    STEP3(pA0, pA1, alA, pB0, pB1, alB, 2, 1, 0, 2);
    STEP3(pB0, pB1, alB, pA0, pA1, alA, 0, 2, 1, 3);
    for (int j = 4; j < NT; j += 6) {
      STEP3(pA0, pA1, alA, pB0, pB1, alB, 1, 0, 2, j);
      STEP3(pB0, pB1, alB, pA0, pA1, alA, 2, 1, 0, j + 1);
      STEP3(pA0, pA1, alA, pB0, pB1, alB, 0, 2, 1, j + 2);
      STEP3(pB0, pB1, alB, pA0, pA1, alA, 1, 0, 2, j + 3);
      STEP3(pA0, pA1, alA, pB0, pB1, alB, 2, 1, 0, j + 4);
      STEP3(pB0, pB1, alB, pA0, pA1, alA, 0, 2, 1, j + 5);
    }
#undef STEP3
    if constexpr (FIX) finishSM_noexp(pB0, pB1, l_reg, pa0, pa1, pa2, pa3); else finishSM_nb(pB0, pB1, alB, l_reg, pa0, pa1, pa2, pa3); SBAR();
    pv_pipe<0>(o, vb0, pa0, pa1, pa2, pa3);
  } else {
    for (int j = 1; j + 1 < NT; j += 2) {
      STEP(pB0, pB1, mnB, alB, pA0, pA1, alA, j);
      STEP(pA0, pA1, mnA, alA, pB0, pB1, alB, j + 1);
    }
    STEP(pB0, pB1, mnB, alB, pA0, pA1, alA, NT - 1);
    if constexpr (FIX) finishSM_noexp(pB0, pB1, l_reg, pa0, pa1, pa2, pa3); else finishSM_nb(pB0, pB1, alB, l_reg, pa0, pa1, pa2, pa3); SBAR();
    pv_pipe<0>(o, vb0 + op, pa0, pa1, pa2, pa3);
  }
  __builtin_amdgcn_s_setprio(0);
  if constexpr (FIX) { if (__any(!(l_reg > 1e-30f && l_reg < 1e30f)) && lane == 0) atomicOr(flag, 1u); }
  if (hi == 0) li_l[r32] = l_reg; asm volatile("s_waitcnt lgkmcnt(0)" ::: "memory");
  int lane_e = lane; asm volatile("" : "+v"(lane_e));
  const int r32e = lane_e & 31, hie = lane_e >> 5;
  float rli[16];
#pragma unroll
  for (int r = 0; r < 16; ++r) rli[r] = __builtin_amdgcn_rcpf(li_l[crow(r, hie)]);
  if constexpr (OBF) {
    bf16_t* Ow = (bf16_t*)Ob + (size_t)(wid * QBLK) * LDO + (unsigned)(4 * hie * LDO + r32e);
#pragma unroll
    for (int r = 0; r < 16; ++r) { const int orow = (r & 3) + 8 * (r >> 2);
#pragma unroll
      for (int d0 = 0; d0 < 4; ++d0) { float val = o[d0][r] * rli[r]; if constexpr (PRBV != 0) val = (val == val && fabsf(val) < 1e20f) ? val * 1e-20f : 0.f; Ow[orow * LDO + d0 * 32] = (bf16_t)f2bf(val); } }
  } else {
    float* Ow = (float*)Ob + (size_t)(wid * QBLK) * LDO + (unsigned)(4 * hie * LDO + r32e);
#pragma unroll
    for (int r = 0; r < 16; ++r) { const int orow = (r & 3) + 8 * (r >> 2);
#pragma unroll
      for (int d0 = 0; d0 < 4; ++d0) Ow[orow * LDO + d0 * 32] = o[d0][r] * rli[r]; }
  }
#undef DMA
#undef RESC
#undef PINIT
#undef STEP
}
#ifndef PROBE_PP
#define PROBE_PP 0
#endif
template <int KOFF, bool DO_QK, bool DO_PV, int PRB>
__device__ __forceinline__ void pp_mseg(f32x16& p0, f32x16& p1, const LAS char* kp, const int* ka, const bf16x8* qr, f32x16* o, int vb, bf16x8 pa0, bf16x8 pa1, bf16x8 pa2, bf16x8 pa3) {
#define TR(off) __builtin_amdgcn_ds_read_tr16_b64_v4i16((LAS s16x4*)(uintptr_t)(unsigned)(vb + (off)))
#define PK(L, H) (bf16x8){L[0], L[1], L[2], L[3], H[0], H[1], H[2], H[3]}
  bf16x8 fa[8], fb[8]; s16x4 lo[4][4], hh[4][4];
  int kl[8];
#pragma unroll
  for (int i = 0; i < 8; ++i) { kl[i] = ka[i]; asm volatile("" : "+v"(kl[i])); }
#define RDK(i) do { fa[i] = *(const LAS bf16x8*)((kp + kl[i]) + KOFF); fb[i] = *(const LAS bf16x8*)((kp + kl[i]) + (KOFF + 8192)); } while (0)
#define RDV(d0, k) do { lo[d0][k] = TR(v_rd_off(d0, k, 0)); hh[d0][k] = TR(v_rd_off(d0, k, 1)); } while (0)
  if constexpr (DO_QK) {
    RDK(0); RDK(1); SBAR();
#define QK_PAIR(i) do { if constexpr (!(PRB & 2)) p0 = __builtin_amdgcn_mfma_f32_32x32x16_bf16(fa[i], qr[i], p0, 0, 0, 0); else p0[i] += __builtin_bit_cast(float, (int)fa[i][0]); \
      if constexpr ((i) + 2 < 8) RDK((i) + 2 < 8 ? (i) + 2 : 0); else if constexpr (DO_PV) { RDV(0, ((i) - 6) * 2); RDV(0, ((i) - 6) * 2 + 1); } SBAR(); \
      if constexpr (!(PRB & 2)) p1 = __builtin_amdgcn_mfma_f32_32x32x16_bf16(fb[i], qr[i], p1, 0, 0, 0); else p1[i] += __builtin_bit_cast(float, (int)fb[i][0]); SBAR(); } while (0)
    QK_PAIR(0); QK_PAIR(1); QK_PAIR(2); QK_PAIR(3); QK_PAIR(4); QK_PAIR(5); QK_PAIR(6); QK_PAIR(7);
#undef QK_PAIR
  } else if constexpr (DO_PV) { RDV(0, 0); RDV(0, 1); RDV(0, 2); RDV(0, 3); SBAR(); }
  if constexpr (DO_PV) {
    const bf16x8 pa[4] = {pa0, pa1, pa2, pa3};
#define PV_SLOT(d0, k) do { if constexpr (!(PRB & 2)) o[d0] = __builtin_amdgcn_mfma_f32_32x32x16_bf16(pa[k], PK(lo[d0][k], hh[d0][k]), o[d0], 0, 0, 0); else o[d0][k] += __builtin_bit_cast(float, (int)lo[d0][k][0] | ((int)hh[d0][k][1] << 16)); if constexpr ((d0) < 3) RDV((d0) < 3 ? (d0) + 1 : 0, k); SBAR(); } while (0)
    PV_SLOT(0, 0); PV_SLOT(0, 1); PV_SLOT(0, 2); PV_SLOT(0, 3); PV_SLOT(1, 0); PV_SLOT(1, 1); PV_SLOT(1, 2); PV_SLOT(1, 3);
    PV_SLOT(2, 0); PV_SLOT(2, 1); PV_SLOT(2, 2); PV_SLOT(2, 3); PV_SLOT(3, 0); PV_SLOT(3, 1); PV_SLOT(3, 2); PV_SLOT(3, 3);
#undef PV_SLOT
  }
#undef RDK
#undef RDV
#undef TR
#undef PK
}
template <int DQ>
__device__ __forceinline__ void pp_softmax(const f32x16& p0, const f32x16& p1, float& m_reg, float& l_reg, float& alpha, bf16x8& pa0, bf16x8& pa1, bf16x8& pa2, bf16x8& pa3) {
  constexpr float SCALE = Sc<DQ>::SCALE, C = SCALE * 1.4426950408889634f;
  float t0 = vmax2(vmax3(vmax3(vmax3(p0[0], p0[1], p0[2]), p0[3], p0[4]), p0[5], p0[6]), p0[7]);
  float t1 = vmax2(vmax3(vmax3(vmax3(p0[8], p0[9], p0[10]), p0[11], p0[12]), p0[13], p0[14]), p0[15]);
  float t2 = vmax2(vmax3(vmax3(vmax3(p1[0], p1[1], p1[2]), p1[3], p1[4]), p1[5], p1[6]), p1[7]);
  float t3 = vmax2(vmax3(vmax3(vmax3(p1[8], p1[9], p1[10]), p1[11], p1[12]), p1[13], p1[14]), p1[15]);
  float pmax = vmax2(vmax3(t0, t1, t2), t3);
  { auto rr = __builtin_amdgcn_permlane32_swap(__float_as_uint(pmax), __float_as_uint(pmax), false, false); pmax = vmax2(__uint_as_float(rr[0]), __uint_as_float(rr[1])); }
  const bool keep = __all(pmax - m_reg <= THR / SCALE);
  const float mn = keep ? m_reg : vmax2(m_reg, pmax);
  alpha = __builtin_amdgcn_exp2f((m_reg - mn) * C); m_reg = mn;
  const float mnC = -mn * C;
  float e0[16], e1[16];
#pragma unroll
  for (int r = 0; r < 16; ++r) { e0[r] = __builtin_amdgcn_exp2f(fmaf(p0[r], C, mnC)); e1[r] = __builtin_amdgcn_exp2f(fmaf(p1[r], C, mnC)); }
  float s0 = 0.f, s1 = 0.f, s2 = 0.f, s3 = 0.f;
#pragma unroll
  for (int r = 0; r < 16; r += 2) { s0 += e0[r]; s1 += e0[r + 1]; s2 += e1[r]; s3 += e1[r + 1]; }
  float ps = (s0 + s1) + (s2 + s3);
  { auto rr = __builtin_amdgcn_permlane32_swap(__float_as_uint(ps), __float_as_uint(ps), false, false); ps = __uint_as_float(rr[0]) + __uint_as_float(rr[1]); }
  l_reg = l_reg * alpha + ps;
#define PK4(E, BASE, OUT) do { unsigned a0 = cvt2(E[BASE + 0], E[BASE + 1]), a1 = cvt2(E[BASE + 2], E[BASE + 3]), b0 = cvt2(E[BASE + 4], E[BASE + 5]), b1 = cvt2(E[BASE + 6], E[BASE + 7]); \
    u32x4 w = {a0, a1, b0, b1}; OUT = *reinterpret_cast<bf16x8*>(&w); } while (0)
  PK4(e0, 0, pa0); PK4(e0, 8, pa1); PK4(e1, 0, pa2); PK4(e1, 8, pa3);
#undef PK4
}
__device__ __forceinline__ void pp_softmax_fix(const f32x16& p0, const f32x16& p1, float& l_reg, bf16x8& pa0, bf16x8& pa1, bf16x8& pa2, bf16x8& pa3) {
  float e0[16], e1[16];
#pragma unroll
  for (int r = 0; r < 16; ++r) { e0[r] = __builtin_amdgcn_exp2f(p0[r]); e1[r] = __builtin_amdgcn_exp2f(p1[r]); }
  float s0 = 0.f, s1 = 0.f, s2 = 0.f, s3 = 0.f;
#pragma unroll
  for (int r = 0; r < 16; r += 2) { s0 += e0[r]; s1 += e0[r + 1]; s2 += e1[r]; s3 += e1[r + 1]; }
  float ps = (s0 + s1) + (s2 + s3);
  { auto rr = __builtin_amdgcn_permlane32_swap(__float_as_uint(ps), __float_as_uint(ps), false, false); ps = __uint_as_float(rr[0]) + __uint_as_float(rr[1]); }
  l_reg += ps;
#define PK4(E, BASE, OUT) do { unsigned a0 = cvt2(E[BASE + 0], E[BASE + 1]), a1 = cvt2(E[BASE + 2], E[BASE + 3]), b0 = cvt2(E[BASE + 4], E[BASE + 5]), b1 = cvt2(E[BASE + 6], E[BASE + 7]); \
    u32x4 w = {a0, a1, b0, b1}; OUT = *reinterpret_cast<bf16x8*>(&w); } while (0)
  PK4(e0, 0, pa0); PK4(e0, 8, pa1); PK4(e1, 0, pa2); PK4(e1, 8, pa3);
#undef PK4
}
template <int DQ, bool ALIBI, bool OBF, int LDQ, int LDK, int LDV, int LDO, bool FIX>
__device__ __forceinline__ void attn_pp(const bf16_t* __restrict__ Qb, const bf16_t* __restrict__ Kh, const bf16_t* __restrict__ Vh,
                                        void* __restrict__ Ob, int q0, int kt0, int NT, char* lds, float sig, unsigned* flag) {
  static_assert(DQ == 128, "ping-pong body: head dim 128");
  constexpr int PRBP = ALIBI ? 0 : PROBE_PP;
  constexpr int R_K = 0, R_V = 65536, OFF_WS2 = 131072;
  int tid = threadIdx.x; asm volatile("" : "+v"(tid));
  const int wid = __builtin_amdgcn_readfirstlane(tid >> 6), lane = tid & 63, r32 = lane & 31, hi = lane >> 5;
  const bool late = wid >= 4;
  LAS char* ldsl = (LAS char*)lds;
  float* ws = (float*)(lds + OFF_WS2) + wid * 64; float* li_l = ws; float* al_l = ws + 32;
  float m_reg = -1e30f, l_reg = 0.f, alpha = 1.f; f32x16 o[4] = {}; bf16x8 qr[8];
  const bf16_t* Qw = Qb + (long)(wid * QBLK + r32) * LDQ + hi * 8;
  constexpr float QC = FIX ? Sc<DQ>::SCALE * 1.4426950408889634f : 1.f;
#pragma unroll
  for (int d0 = 0; d0 < 8; ++d0) { qr[d0] = ld8(Qw + d0 * 16); if constexpr (FIX) qr[d0] = scale_frag(qr[d0], QC); }
  unsigned voK[2], voV[2];
#pragma unroll
  for (int i = 0; i < 2; ++i) { const int q = wid * 2 + i;
    { const int row = q * 4 + (lane >> 4), c = (lane & 15) ^ (row & 15); voK[i] = (unsigned)(row * LDK + c * 8) * 2u; }
    { const int st = q * 2 + (lane >> 5), w = lane & 31, kk = (st >> 2) * 8 + (w >> 2), c = (st & 3) * 32 + (w & 3) * 8, k = (kk & ~0xC) | ((kk & 4) << 1) | ((kk & 8) >> 1);
      voV[i] = (unsigned)(k * LDV + c) * 2u; } }
  int ka[8];
#pragma unroll
  for (int i = 0; i < 8; ++i) { ka[i] = KSWZ(r32, (i * 16 + hi * 8) * 2); asm volatile("" : "+v"(ka[i])); }
  int vb0 = (int)(uintptr_t)ldsl + R_V + v_rd_base(lane); asm volatile("" : "+v"(vb0));
  const int qw0 = q0 + wid * QBLK;
  const float dq0 = (float)(qw0 + r32 - 4 * hi);
#define DMA(slot, tile) do { const size_t k0_ = (size_t)(kt0 + (tile)) * KVBLK; const char* Vt_ = (const char*)Vh + k0_ * (LDV * 2); const char* Kt_ = (const char*)Kh + k0_ * (LDK * 2); \
    LAS char* sl_ = ldsl + (slot) * 16384 + wid * 2048; \
    glds16s(voV[0], Vt_, (unsigned)(uintptr_t)(LAS char*)(sl_ + R_V)); \
    glds16s(voV[1], Vt_, (unsigned)(uintptr_t)(LAS char*)(sl_ + R_V + 1024)); \
    glds16s(voK[0], Kt_, (unsigned)(uintptr_t)(LAS char*)(sl_ + R_K)); \
    glds16s(voK[1], Kt_, (unsigned)(uintptr_t)(LAS char*)(sl_ + R_K + 1024)); } while (0)
#define RESC(a) do { if (__any((a) < 1.f)) { if (hi == 0) al_l[r32] = (a); asm volatile("s_waitcnt lgkmcnt(0)" ::: "memory"); \
    _Pragma("unroll") for (int d = 0; d < 4; ++d) _Pragma("unroll") for (int r = 0; r < 16; ++r) o[d][r] *= al_l[crow(r, hi)]; } } while (0)
#define PINIT(tj) do { if constexpr (ALIBI) { const int k0_ = (kt0 + (tj)) * KVBLK; alibi_init(pc0, pc1, dq0 - (float)k0_, sig, qw0 - k0_); } else { pc0 = f32x16{}; pc1 = f32x16{}; } } while (0)
#define BAR() __builtin_amdgcn_s_barrier()
  f32x16 pc0, pc1; bf16x8 pa0, pa1, pa2, pa3;
#define PP_STEP(SC, SP, SN2, tj, FIRST) do { \
    BAR(); if ((tj) + 2 < NT) DMA(SN2, (tj) + 2); SBAR(); \
    { int vb_ = vb0; asm volatile("" : "+v"(vb_)); pp_mseg<R_K + (SC) * 16384, true, !(FIRST), PRBP>(pc0, pc1, ldsl, ka, qr, o, vb_ + (SP) * 16384, pa0, pa1, pa2, pa3); } SBAR(); \
    if ((tj) + 2 < NT) asm volatile("s_waitcnt vmcnt(4)" ::: "memory"); else asm volatile("s_waitcnt vmcnt(0)" ::: "memory"); \
    BAR(); \
    if constexpr (FIX) { pp_softmax_fix(pc0, pc1, l_reg, pa0, pa1, pa2, pa3); } else if constexpr (!(PRBP & 1)) { pp_softmax<DQ>(pc0, pc1, m_reg, l_reg, alpha, pa0, pa1, pa2, pa3); RESC(alpha); } else { pa0 = qr[0]; pa1 = qr[1]; pa2 = qr[2]; pa3 = qr[3]; l_reg += pc0[0]; } \
    if ((tj) + 1 < NT) PINIT((tj) + 1); SBAR(); } while (0)
  DMA(0, 0); DMA(1, 1);
  asm volatile("s_waitcnt vmcnt(4)" ::: "memory");
  PINIT(0);
  if (late) BAR();
  PP_STEP(0, 3, 2, 0, true);
  PP_STEP(1, 0, 3, 1, false);
  PP_STEP(2, 1, 0, 2, false);
  PP_STEP(3, 2, 1, 3, false);
  for (int j = 4; j < NT; j += 4) {
    PP_STEP(0, 3, 2, j, false);
    PP_STEP(1, 0, 3, j + 1, false);
    PP_STEP(2, 1, 0, j + 2, false);
    PP_STEP(3, 2, 1, j + 3, false);
  }
  BAR();
  { int vb_ = vb0; asm volatile("" : "+v"(vb_)); pp_mseg<0, false, true, PRBP>(pc0, pc1, ldsl, ka, qr, o, vb_ + 3 * 16384, pa0, pa1, pa2, pa3); }
  if (!late) BAR();
  if constexpr (FIX) { if (__any(!(l_reg > 1e-30f && l_reg < 1e30f)) && lane == 0) atomicOr(flag, 1u); }
  if (hi == 0) li_l[r32] = l_reg; asm volatile("s_waitcnt lgkmcnt(0)" ::: "memory");
  int lane_e = lane; asm volatile("" : "+v"(lane_e));
  const int r32e = lane_e & 31, hie = lane_e >> 5;
  float rli[16];
#pragma unroll
  for (int r = 0; r < 16; ++r) rli[r] = __builtin_amdgcn_rcpf(li_l[crow(r, hie)]);
  if constexpr (OBF) {
    bf16_t* Ow = (bf16_t*)Ob + (size_t)(wid * QBLK) * LDO + (unsigned)(4 * hie * LDO + r32e);
#pragma unroll
    for (int r = 0; r < 16; ++r) { const int orow = (r & 3) + 8 * (r >> 2);
#pragma unroll
      for (int d0 = 0; d0 < 4; ++d0) { float val = o[d0][r] * rli[r]; if constexpr (PRBP != 0) val = (val == val && fabsf(val) < 1e20f) ? val * 1e-20f : 0.f; Ow[orow * LDO + d0 * 32] = (bf16_t)f2bf(val); } }
  } else {
    float* Ow = (float*)Ob + (size_t)(wid * QBLK) * LDO + (unsigned)(4 * hie * LDO + r32e);
#pragma unroll
    for (int r = 0; r < 16; ++r) { const int orow = (r & 3) + 8 * (r >> 2);
#pragma unroll
      for (int d0 = 0; d0 < 4; ++d0) Ow[orow * LDO + d0 * 32] = o[d0][r] * rli[r]; }
  }
#undef DMA
#undef RESC
#undef PINIT
#undef BAR
#undef PP_STEP
}
}

constexpr int N_IN = 24;
enum { I_X = 0, I_AB_WIN, I_AB_QN, I_AB_KN, I_LQ1, I_LK1, I_LQ2, I_LK2, I_SUBLN, I_AB_WOUT, I_M_WIN, I_M_QN, I_M_KVN, I_M_WUQ, I_M_WUKV, I_M_WOUT,
       I_LNM_G, I_LNM_B, I_ROUTER, I_WGATE, I_WUP, I_WDOWN, I_LNF_G, I_LNF_B };
struct Args { const float* in[N_IN]; float* out; unsigned char* ws; int ph_lo, ph_hi; };
struct Frame { LAS unsigned char* lds; char* ldsg; int tid, lane, wave, G, gw, NGW; };

__device__ __forceinline__ void transpose_item(const float* W, int K, int N, bf16_t* WT, int k0, int n0, int drow0, LAS float* scr, int lane) {
#pragma unroll 8
    for (int i = 0; i < 32; ++i) { const int kk = 2 * i + (lane >> 5); scr[kk * 33 + (lane & 31)] = W[(size_t)(k0 + kk) * N + n0 + (lane & 31)]; }
    LDS_WAIT(); asm volatile("" ::: "memory");
    const int c = lane & 7;
#pragma unroll
    for (int j = 0; j < 4; ++j) { const int n = (lane >> 3) + 8 * j; const LAS float* s = scr + (8 * c) * 33 + n;
        u32x4 o; o.x = pk2(s[0 * 33], s[1 * 33]); o.y = pk2(s[2 * 33], s[3 * 33]); o.z = pk2(s[4 * 33], s[5 * 33]); o.w = pk2(s[6 * 33], s[7 * 33]);
        *(u32x4*)(WT + (size_t)(drow0 + n) * K + k0 + 8 * c) = o; }
    LDS_WAIT(); asm volatile("" ::: "memory");
}
template <int MODE>
__device__ __forceinline__ void transpose_matrix(const Frame& F, const float* W, int K, int N, bf16_t* WT, LAS float* scr) {
    const int nblk = N / 32, nitems = (K / 64) * nblk;
    for (int it = F.gw; it < nitems; it += F.NGW) {
        const int kb = it / nblk, nb = it % nblk, n0 = 32 * nb;
        int drow0 = n0;
        if (MODE == 1) drow0 = (n0 >> 7) * 256 + (n0 & 127);
        if (MODE == 2) drow0 = (n0 >> 7) * 256 + 128 + (n0 & 127);
        transpose_item(W, K, N, WT, 64 * kb, n0, drow0, scr, F.lane);
    }
}
__device__ __forceinline__ void transpose_item_f8(const float* W, int K, int N, unsigned char* WT, int k0, int n0, int drow0, float sc, LAS float* scr, int lane) {
#pragma unroll 8
    for (int i = 0; i < 32; ++i) { const int kk = 2 * i + (lane >> 5); scr[kk * 33 + (lane & 31)] = __builtin_nontemporal_load(&W[(size_t)(k0 + kk) * N + n0 + (lane & 31)]); }
    LDS_WAIT(); asm volatile("" ::: "memory");
    const int c = lane & 3;
#pragma unroll
    for (int j = 0; j < 2; ++j) { const int n = (lane >> 2) + 16 * j; const LAS float* s = scr + (16 * c) * 33 + n;
        u32x4 o; o.x = pk4_fp8(s[0 * 33] * sc, s[1 * 33] * sc, s[2 * 33] * sc, s[3 * 33] * sc); o.y = pk4_fp8(s[4 * 33] * sc, s[5 * 33] * sc, s[6 * 33] * sc, s[7 * 33] * sc);
        o.z = pk4_fp8(s[8 * 33] * sc, s[9 * 33] * sc, s[10 * 33] * sc, s[11 * 33] * sc); o.w = pk4_fp8(s[12 * 33] * sc, s[13 * 33] * sc, s[14 * 33] * sc, s[15 * 33] * sc);
        *(u32x4*)(WT + (size_t)(drow0 + n) * K + k0 + 16 * c) = o; }
    LDS_WAIT(); asm volatile("" ::: "memory");
}
__device__ __forceinline__ void transpose_pair_f8(const float* W, int K, int N, unsigned char* WT, int k0, int n0, int drow0, float sc, LAS float* scr, int lane) {
    const int r8 = lane >> 3, c4 = (lane & 7) * 4;
    const float* src = W + (size_t)(k0 + r8) * N + n0 + c4;
    f32x4 va[8], vb[8];
#pragma unroll
    for (int i = 0; i < 8; ++i) va[i] = __builtin_nontemporal_load((const f32x4*)(src + (size_t)(8 * i) * N));
#pragma unroll
    for (int i = 0; i < 8; ++i) vb[i] = __builtin_nontemporal_load((const f32x4*)(src + (size_t)(64 + 8 * i) * N));
#pragma unroll
    for (int h = 0; h < 2; ++h) {
#pragma unroll
        for (int i = 0; i < 8; ++i) { const f32x4 v = h ? vb[i] : va[i]; LAS float* d = scr + (8 * i + r8) * 33 + c4; d[0] = v.x; d[1] = v.y; d[2] = v.z; d[3] = v.w; }
        LDS_WAIT(); asm volatile("" ::: "memory");
        const int c = lane & 3;
#pragma unroll
        for (int j = 0; j < 2; ++j) { const int n = (lane >> 2) + 16 * j; const LAS float* p = scr + (16 * c) * 33 + n;
            u32x4 o; o.x = pk4_fp8(p[0 * 33] * sc, p[1 * 33] * sc, p[2 * 33] * sc, p[3 * 33] * sc); o.y = pk4_fp8(p[4 * 33] * sc, p[5 * 33] * sc, p[6 * 33] * sc, p[7 * 33] * sc);
            o.z = pk4_fp8(p[8 * 33] * sc, p[9 * 33] * sc, p[10 * 33] * sc, p[11 * 33] * sc); o.w = pk4_fp8(p[12 * 33] * sc, p[13 * 33] * sc, p[14 * 33] * sc, p[15 * 33] * sc);
            *(u32x4*)(WT + (size_t)(drow0 + n) * K + k0 + 64 * h + 16 * c) = o; }
        LDS_WAIT(); asm volatile("" ::: "memory");
    }
}
template <int MODE>
__device__ __forceinline__ void transpose_matrix_pairs_f8(const float* W, int K, int N, unsigned char* WT, float sc, LAS float* scr, int gw, int ngw, int lane) {
    const int nblk = N / 32, nitems = (K / 128) * nblk;
    for (int it = gw; it < nitems; it += ngw) {
        const int kb = it / nblk, nb = it % nblk, n0 = 32 * nb;
        int drow0 = n0;
        if (MODE == 1) drow0 = (n0 >> 7) * 256 + (n0 & 127);
        if (MODE == 2) drow0 = (n0 >> 7) * 256 + 128 + (n0 & 127);
        transpose_pair_f8(W, K, N, WT, 128 * kb, n0, drow0, sc, scr, lane);
    }
}
template <int MODE>
__device__ __forceinline__ void transpose_matrix_f8(const Frame& F, const float* W, int K, int N, unsigned char* WT, float sc, LAS float* scr) {
    const int nblk = N / 32, nitems = (K / 64) * nblk;
    for (int it = F.gw; it < nitems; it += F.NGW) {
        const int kb = it / nblk, nb = it % nblk, n0 = 32 * nb;
        int drow0 = n0;
        if (MODE == 1) drow0 = (n0 >> 7) * 256 + (n0 & 127);
        if (MODE == 2) drow0 = (n0 >> 7) * 256 + 128 + (n0 & 127);
        transpose_item_f8(W, K, N, WT, 64 * kb, n0, drow0, sc, scr, F.lane);
    }
}
__device__ __forceinline__ void sincos_d(double a, double& s, double& c) {
    const double k = rint(a * 0.15915494309189535);
    double r = fma(-k, 6.283185307179586, a); r = fma(-k, 2.4492935982947064e-16, r);
    const double x = r * 0.125, x2 = x * x;
    double sp = x * (1.0 + x2 * (-1.0 / 6 + x2 * (1.0 / 120 + x2 * (-1.0 / 5040 + x2 * (1.0 / 362880 + x2 * (-1.0 / 39916800 + x2 * (1.0 / 6227020800.0)))))));
    double cp = 1.0 + x2 * (-0.5 + x2 * (1.0 / 24 + x2 * (-1.0 / 720 + x2 * (1.0 / 40320 + x2 * (-1.0 / 3628800 + x2 * (1.0 / 479001600.0 + x2 * (-1.0 / 87178291200.0)))))));
#pragma unroll
    for (int i = 0; i < 3; ++i) { const double s2 = 2.0 * sp * cp, c2 = cp * cp - sp * sp; sp = s2; cp = c2; }
    s = sp; c = cp;
}
__device__ __forceinline__ void phase_prologue(const Frame& F, const Args& a) {
    LAS float* scr = (LAS float*)(F.lds + RING_OFF + F.wave * 16384);
    unsigned char* ws = a.ws;
    for (int id = blockIdx.x * NTHR + F.tid; id < TAB_N; id += F.G * NTHR) {
        int pos, i, nf;
        if (id < TAB_C128) { pos = id / 32; i = id % 32; nf = 32; }
        else if (id < TAB_R64) { pos = (id - TAB_C128) / 32; i = id % 32; nf = 32; }
        else if (id < TAB_C64) { pos = (id - TAB_R64) / 16; i = id % 16; nf = 16; }
        else { pos = (id - TAB_C64) / 16; i = id % 16; nf = 16; }
        const int steps = nf == 32 ? i : 2 * i;
        double f = 1.0; for (int j = 0; j < steps; ++j) f *= 0.7498942093324559;
        double sn, cs; sincos_d((double)pos * f, sn, cs);
        ((f32x2*)(ws + WS_TAB))[id] = (f32x2){(float)cs, (float)sn};
    }
    { const f32x4* x4 = (const f32x4*)a.in[I_X]; u32x2* xb = (u32x2*)(ws + WS_XB);
      const size_t n4 = (size_t)S * DM / 4, stride = (size_t)F.G * NTHR;
      size_t i = (size_t)blockIdx.x * NTHR + F.tid;
      for (; i + 7 * stride < n4; i += 8 * stride) {
          f32x4 v[8];
#pragma unroll
          for (int j = 0; j < 8; ++j) v[j] = __builtin_nontemporal_load(x4 + i + j * stride);
#pragma unroll
          for (int j = 0; j < 8; ++j) xb[i + j * stride] = (u32x2){pk2(v[j].x, v[j].y), pk2(v[j].z, v[j].w)};
      }
      for (; i < n4; i += stride) { const f32x4 v = x4[i]; xb[i] = (u32x2){pk2(v.x, v.y), pk2(v.z, v.w)}; } }
    { u32x4* z = (u32x4*)(ws + WS_WMIN + (size_t)1088 * DM * 2); const size_t n = (size_t)(MLA_IN_PAD - 1088) * DM * 2 / 16;
      for (size_t i = (size_t)blockIdx.x * NTHR + F.tid; i < n; i += (size_t)F.G * NTHR) z[i] = (u32x4){0u, 0u, 0u, 0u}; }
    transpose_matrix<0>(F, a.in[I_AB_WIN], DM, AB_IN, (bf16_t*)(ws + WS_WIN), scr);
}
__device__ __forceinline__ void transpose_pair_bf16(const float* W, int K, int N, bf16_t* WT, int k0, int n0, LAS float* scr, int lane) {
    const int r8 = lane >> 3, c4 = (lane & 7) * 4;
    const float* src = W + (size_t)(k0 + r8) * N + n0 + c4;
    f32x4 va[8], vb[8];
#pragma unroll
    for (int i = 0; i < 8; ++i) va[i] = __builtin_nontemporal_load((const f32x4*)(src + (size_t)(8 * i) * N));
#pragma unroll
    for (int i = 0; i < 8; ++i) vb[i] = __builtin_nontemporal_load((const f32x4*)(src + (size_t)(64 + 8 * i) * N));
#pragma unroll
    for (int h = 0; h < 2; ++h) {
#pragma unroll
        for (int i = 0; i < 8; ++i) { const f32x4 v = h ? vb[i] : va[i]; LAS float* d = scr + (8 * i + r8) * 33 + c4; d[0] = v.x; d[1] = v.y; d[2] = v.z; d[3] = v.w; }
        LDS_WAIT(); asm volatile("" ::: "memory");
        const int c = lane & 7;
#pragma unroll
        for (int j = 0; j < 4; ++j) { const int n = (lane >> 3) + 8 * j; const LAS float* p = scr + (8 * c) * 33 + n;
            u32x4 o; o.x = pk2(p[0 * 33], p[1 * 33]); o.y = pk2(p[2 * 33], p[3 * 33]); o.z = pk2(p[4 * 33], p[5 * 33]); o.w = pk2(p[6 * 33], p[7 * 33]);
            *(u32x4*)(WT + (size_t)(n0 + n) * K + k0 + 64 * h + 8 * c) = o; }
        LDS_WAIT(); asm volatile("" ::: "memory");
    }
}
__device__ __forceinline__ void transpose_matrix_pairs_bf16(const float* W, int K, int N, bf16_t* WT, LAS float* scr, int gw, int ngw, int lane) {
    const int nblk = N / 32, nitems = (K / 128) * nblk;
    for (int it = gw; it < nitems; it += ngw) { const int kb = it / nblk, nb = it % nblk; transpose_pair_bf16(W, K, N, WT, 128 * kb, 32 * nb, scr, lane); }
}
constexpr int N_CONV = 64;
__device__ __forceinline__ void convert_experts(const Frame& F, const Args& a) {
    LAS float* scr = (LAS float*)(F.lds + RING_OFF + F.wave * 16384);
    unsigned char* ws = a.ws;
    const int gw = (int)blockIdx.x * NWAVES + F.wave, ngw = N_CONV * NWAVES;
    for (int le = 0; le < 2 * NE; ++le) {
        transpose_matrix_pairs_f8<1>(a.in[I_WGATE] + (size_t)le * DM * FF, DM, FF, (unsigned char*)(ws + WS_WGU) + (size_t)le * 2 * FF * DM, W8_GU, scr, gw, ngw, F.lane);
        transpose_matrix_pairs_f8<2>(a.in[I_WUP] + (size_t)le * DM * FF, DM, FF, (unsigned char*)(ws + WS_WGU) + (size_t)le * 2 * FF * DM, W8_GU, scr, gw, ngw, F.lane);
        transpose_matrix_pairs_f8<0>(a.in[I_WDOWN] + (size_t)le * FF * DM, FF, DM, (unsigned char*)(ws + WS_WD) + (size_t)le * DM * FF, W8_D, scr, gw, ngw, F.lane);
    }
    transpose_matrix_pairs_bf16(a.in[I_AB_WOUT], DM, DM, (bf16_t*)(ws + WS_WOUT), scr, gw, ngw, F.lane);
    transpose_matrix_pairs_bf16(a.in[I_M_WIN], DM, 1088, (bf16_t*)(ws + WS_WMIN), scr, gw, ngw, F.lane);
    transpose_matrix_pairs_bf16(a.in[I_M_WUQ], 512, 3072, (bf16_t*)(ws + WS_WUQ), scr, gw, ngw, F.lane);
    transpose_matrix_pairs_bf16(a.in[I_M_WUKV], 512, 4096, (bf16_t*)(ws + WS_WUKV), scr, gw, ngw, F.lane);
    transpose_matrix_pairs_bf16(a.in[I_M_WOUT], DM, DM, (bf16_t*)(ws + WS_WMOUT), scr, gw, ngw, F.lane);
}
__device__ __forceinline__ void phase_prep0(const Frame& F, const Args& a) {
    const float* HQK = (const float*)(a.ws + WS_SCR + SC_HQK);
    bf16_t* AQB = (bf16_t*)(a.ws + WS_SCR + SC_AQB); bf16_t* AKB = (bf16_t*)(a.ws + WS_SCR + SC_AKB);
    const f32x2* tab = (const f32x2*)(a.ws + WS_TAB);
    const int l = F.lane, half = l >> 5, ll = l & 31, i0 = (2 * ll) & 31;
    for (int p = F.gw; p < S * 10; p += F.NGW) {
        const int t = p / 10, hh = p % 10;
        const f32x2 v = *(const f32x2*)(HQK + (size_t)t * 1280 + hh * 128 + 2 * l);
        const float ss = wave_sum(v.x * v.x + v.y * v.y);
        const float r = 1.0f / sqrtf(ss * (1.f / 128) + NORM_EPS);
        const float* w = hh < 8 ? a.in[I_AB_QN] : a.in[I_AB_KN];
        const f32x2 g = *(const f32x2*)(w + 2 * l);
        const float y0 = v.x * r * g.x, y1 = v.y * r * g.y;
        const float q0 = __shfl_xor(y0, 16), q1 = __shfl_xor(y1, 16);
        const f32x2* cs = half == 0 ? tab + TAB_R128 + (t >> 6) * 32 + i0 : tab + TAB_C128 + (t & 63) * 32 + i0;
        const f32x2 c0 = cs[0], c1 = cs[1];
        float o0, o1;
        if (ll < 16) { o0 = y0 * c0.x - q0 * c0.y; o1 = y1 * c1.x - q1 * c1.y; }
        else         { o0 = y0 * c0.x + q0 * c0.y; o1 = y1 * c1.x + q1 * c1.y; }
        unsigned* dst = hh < 8 ? (unsigned*)(AQB + (size_t)t * 1024 + hh * 128) : (unsigned*)(AKB + (size_t)t * 256 + (hh - 8) * 128);
        dst[l] = pk2(o0, o1);
    }
    { const bf16_t* HB = (const bf16_t*)(a.ws + WS_SCR + SC_HB); unsigned* N2 = (unsigned*)(a.ws + WS_CTL) + CW_NORM2;
      float mq = 0.f, mk = 0.f;
      for (int t = F.gw; t < S; t += F.NGW) {
#pragma unroll
          for (int which = 0; which < 2; ++which) {
              const bf16x8* p = (const bf16x8*)(HB + (size_t)t * HB_LD + (which ? 1280 : 256) + 16 * l);
              const bf16x8 v0 = p[0], v1 = p[1]; float ss = 0.f;
#pragma unroll
              for (int e = 0; e < 8; ++e) { const float x = bf2f((unsigned short)v0[e]), y = bf2f((unsigned short)v1[e]); ss += x * x + y * y; }
              ss += __shfl_xor(ss, 1); ss += __shfl_xor(ss, 2); ss += __shfl_xor(ss, 4);
              if (which) mk = fmaxf(mk, ss); else mq = fmaxf(mq, ss);
          }
      }
      if ((l & 7) == 0) { atomicMax(&N2[l >> 3], __float_as_uint(mq)); atomicMax(&N2[8 + (l >> 3)], __float_as_uint(mk)); }
    }
}
template <bool FIX>
__device__ __forceinline__ void phase_attn0(const Frame& F, const Args& a, int qword) {
    unsigned char* sc = a.ws + WS_SCR;
    const bf16_t* AQB = (const bf16_t*)(sc + SC_AQB); const bf16_t* AKB = (const bf16_t*)(sc + SC_AKB); const bf16_t* HB = (const bf16_t*)(sc + SC_HB);
    bf16_t* CAT = (bf16_t*)(sc + SC_CAT); float* DO = (float*)(sc + SC_DO);
    constexpr int NU = 24 * 64;
    unsigned* qh = (unsigned*)(a.ws + WS_CTL) + CW_QHEAD0 + qword; unsigned* aflag = (unsigned*)(a.ws + WS_CTL) + CW_AFLAG; const float* N2 = (const float*)((const unsigned*)(a.ws + WS_CTL) + CW_NORM2);
    volatile LAS int* uslot = (volatile LAS int*)(F.lds + MISC_OFF + 64);
    for (;;) {
        if (F.tid == 0) uslot[0] = (int)__hip_atomic_fetch_add(qh, 1u, __ATOMIC_RELAXED, __HIP_MEMORY_SCOPE_AGENT);
        __syncthreads();
        const int u = uslot[0];
        __syncthreads();
        if (u >= NU) break;
        if (u < 512) {
            const int h = u >> 6, qb = u & 63, q0 = qb * 256, kvh = h >> 2;
            att::attn_ring<128, false, true, 1024, 256, HB_LD, DM, FIX>(AQB + (size_t)q0 * 1024 + h * 128, AKB + kvh * 128, HB + kvh * 128, nullptr,
                                                                          CAT + (size_t)q0 * DM + h * 128, q0, 0, S / 64, F.ldsg, 0.f, nullptr, nullptr, aflag);
        } else {
            const int r = u - 512, h = 3 - (r >> 8), d = (r >> 6) & 3, m = d >> 1, vh = d & 1, qb = r & 63, q0 = qb * 256;
            const float slope = __builtin_amdgcn_exp2f(-2.0f * (float)(h + 1));
            const float sig = FIX ? slope * 1.4426950408889634f : slope * 11.313708498984761f;
            const float Bb = sqrtf(N2[h * 2 + m] * N2[8 + h * 2 + m]) * 0.08838834764831845f;
            const float Df = (2.f * Bb + 112.f) / slope + 1.f;
            const int D = Df > 40000.f ? 40000 : (int)Df;
            int kt0 = (q0 - D) >> 6; if (kt0 < 0) kt0 = 0;
            int kt1 = ((q0 + 255 + D) >> 6) + 1; if (kt1 > S / 64) kt1 = S / 64;
            while ((kt1 - kt0) & 3) { if (kt1 < S / 64) ++kt1; else --kt0; }
            att::attn_ring<128, true, false, HB_LD, HB_LD, HB_LD, DM, FIX>(HB + (size_t)q0 * HB_LD + 256 + (h * 2 + m) * 128, HB + 1280 + (h * 2 + m) * 128, HB + 2304 + h * 256 + vh * 128, nullptr,
                                                                             DO + (size_t)q0 * DM + (h * 2 + m) * 256 + vh * 128, q0, kt0, kt1 - kt0, F.ldsg, sig, nullptr, nullptr, aflag);
        }
        __syncthreads();
    }
}
__device__ __forceinline__ void phase_combine(const Frame& F, const Args& a) {
    const float* DO = (const float*)(a.ws + WS_SCR + SC_DO); bf16_t* CAT = (bf16_t*)(a.ws + WS_SCR + SC_CAT);
    const int l = F.lane;
    const float s1 = wave_sum(a.in[I_LQ1][l] * a.in[I_LK1][l] + a.in[I_LQ1][l + 64] * a.in[I_LK1][l + 64]);
    const float s2 = wave_sum(a.in[I_LQ2][l] * a.in[I_LK2][l] + a.in[I_LQ2][l + 64] * a.in[I_LK2][l + 64]);
    const float lam_init = 0.2f;
    const float lam = expf(s1) - expf(s2) + lam_init;
    const f32x4 sg = *(const f32x4*)(a.in[I_SUBLN] + 4 * l);
    for (int p = F.gw; p < S * 4; p += F.NGW) {
        const int t = p >> 2, h = p & 3;
        const f32x4 o1 = *(const f32x4*)(DO + (size_t)t * DM + (h * 2) * 256 + 4 * l), o2 = *(const f32x4*)(DO + (size_t)t * DM + (h * 2 + 1) * 256 + 4 * l);
        const f32x4 o = o1 - o2 * lam;
        const float ss = wave_sum(o.x * o.x + o.y * o.y + o.z * o.z + o.w * o.w);
        const float r = (1.0f / sqrtf(ss * (1.f / 256) + NORM_EPS));
        const float k = 1.f - lam_init;
        *(u32x2*)(CAT + (size_t)t * DM + 1024 + h * 256 + 4 * l) = (u32x2){pk2(o.x * r * sg.x * k, o.y * r * sg.y * k), pk2(o.z * r * sg.z * k, o.w * r * sg.w * k)};
    }
}
__device__ __forceinline__ void phase_ln_router(const Frame& F, const Args& a, int layer) {
    LAS float* wl = (LAS float*)(F.lds + RING_OFF);
    const float* wr = a.in[I_ROUTER] + (size_t)layer * DM * NE;
    for (int i = F.tid; i < DM * NE; i += NTHR) wl[(i & 15) * DM + (i >> 4)] = wr[i];
    __syncthreads();
    float* Y = (float*)(a.ws + WS_X1); unsigned char* XB8 = (unsigned char*)(a.ws + WS_XB); float* AFF = (float*)(a.ws + WS_SEL + SEL_AFF);
    const float* G = a.in[I_LNM_G] + layer * DM; const float* Bv = a.in[I_LNM_B] + layer * DM;
    const int l = F.lane;
    for (int t = F.gw; t < S; t += F.NGW) {
        f32x4* yr = (f32x4*)(Y + (size_t)t * DM) + l;
        f32x4 v[8]; float s = 0.f;
#pragma unroll
        for (int j = 0; j < 8; ++j) { v[j] = yr[64 * j]; s += (v[j].x + v[j].y) + (v[j].z + v[j].w); }
        const float mean = wave_sum(s) * (1.f / DM); float s2 = 0.f;
#pragma unroll
        for (int j = 0; j < 8; ++j) { v[j] = v[j] - mean; s2 += (v[j].x * v[j].x + v[j].y * v[j].y) + (v[j].z * v[j].z + v[j].w * v[j].w); }
        const float rstd = 1.f / sqrtf(wave_sum(s2) * (1.f / DM) + LN_EPS);
        unsigned* xb = (unsigned*)(XB8 + (size_t)t * DM) + l;
#pragma unroll
        for (int j = 0; j < 8; ++j) { const f32x4 g = *((const f32x4*)G + 64 * j + l), b = *((const f32x4*)Bv + 64 * j + l);
            v[j] = v[j] * rstd * g + b; yr[64 * j] = v[j]; xb[64 * j] = pk4_fp8(v[j].x, v[j].y, v[j].z, v[j].w); }
        float ac[NE];
#pragma unroll
        for (int e = 0; e < NE; ++e) { float acc = 0.f;
#pragma unroll
            for (int j = 0; j < 8; ++j) { const f32x4 w = *((const LAS f32x4*)(wl + e * DM) + 64 * j + l); acc += (v[j].x * w.x + v[j].y * w.y) + (v[j].z * w.z + v[j].w * w.w); }
            ac[e] = acc; __builtin_amdgcn_sched_barrier(0); }
        float k8[8], k4[4], k2[2], k1;
        const bool b5 = l & 32, b4 = l & 16, b3 = l & 8, b2 = l & 4;
#pragma unroll
        for (int i = 0; i < 8; ++i) { const float send = b5 ? ac[i] : ac[8 + i], keep = b5 ? ac[8 + i] : ac[i]; k8[i] = keep + __shfl_xor(send, 32); }
#pragma unroll
        for (int i = 0; i < 4; ++i) { const float send = b4 ? k8[i] : k8[4 + i], keep = b4 ? k8[4 + i] : k8[i]; k4[i] = keep + __shfl_xor(send, 16); }
#pragma unroll
        for (int i = 0; i < 2; ++i) { const float send = b3 ? k4[i] : k4[2 + i], keep = b3 ? k4[2 + i] : k4[i]; k2[i] = keep + __shfl_xor(send, 8); }
        { const float send = b2 ? k2[0] : k2[1], keep = b2 ? k2[1] : k2[0]; k1 = keep + __shfl_xor(send, 4); }
        k1 += __shfl_xor(k1, 2); k1 += __shfl_xor(k1, 1);
        const int my_e = (b5 ? 8 : 0) + (b4 ? 4 : 0) + (b3 ? 2 : 0) + (b2 ? 1 : 0);
        const float mx = wave_max(k1);
        const float p = expf(k1 - mx);
        const float sum = wave_sum(p) * 0.25f;
        if ((l & 3) == 0) AFF[(size_t)t * NE + my_e] = p / sum;
    }
    __syncthreads();
}
__device__ __forceinline__ void phase_topk(const Frame& F, const Args& a) {
    if (blockIdx.x >= NE) return;
    const int e = blockIdx.x, tid = F.tid, l = F.lane;
    LAS unsigned* keys = (LAS unsigned*)(F.lds + RING_OFF);
    LAS unsigned* hist = keys + 16896;
    LAS unsigned* sel = hist + 8 * 257 + 8;
    LAS unsigned* wtot = sel + 8;
    const float* AFF = (const float*)(a.ws + WS_SEL + SEL_AFF);
    int* IDX = (int*)(a.ws + WS_SEL + SEL_IDX); float* GATE = (float*)(a.ws + WS_SEL + SEL_GATE); int* TOKSLOT = (int*)(a.ws + WS_SEL + SEL_TOKSLOT);
    for (int i = tid; i < S; i += NTHR) keys[i + (i >> 5)] = __float_as_uint(AFF[(size_t)i * NE + e]);
    if (tid == 0) { sel[0] = 0u; sel[1] = (unsigned)CAP; }
    __syncthreads();
    for (int pass = 0; pass < 4; ++pass) {
        const int shift = 24 - 8 * pass;
        for (int i = tid; i < 8 * 257; i += NTHR) hist[i] = 0u;
        __syncthreads();
        const unsigned prefix = sel[0], mask = pass == 0 ? 0u : (0xFFFFFFFFu << (shift + 8));
        for (int i = tid; i < S; i += NTHR) { const unsigned k = keys[i + (i >> 5)];
            if ((k & mask) == prefix) __hip_atomic_fetch_add(&hist[(l & 7) * 257 + ((k >> shift) & 255u)], 1u, __ATOMIC_RELAXED, __HIP_MEMORY_SCOPE_WORKGROUP); }
        __syncthreads();
        if (F.wave == 0) {
            const unsigned remaining = sel[1];
            unsigned h0 = 0u, h1 = 0u, h2 = 0u, h3 = 0u;
#pragma unroll
            for (int cp = 0; cp < 8; ++cp) { h0 += hist[cp * 257 + 255 - 4 * l]; h1 += hist[cp * 257 + 254 - 4 * l]; h2 += hist[cp * 257 + 253 - 4 * l]; h3 += hist[cp * 257 + 252 - 4 * l]; }
            const unsigned sm = h0 + h1 + h2 + h3;
            unsigned incl = sm;
#pragma unroll
            for (int o = 1; o < 64; o <<= 1) { const unsigned n = __shfl_up(incl, o); if (l >= o) incl += n; }
            const unsigned excl = incl - sm;
            if (excl < remaining && remaining <= incl) {
                unsigned c = excl; int bin;
                if (c + h0 >= remaining) bin = 255 - 4 * l;
                else { c += h0; if (c + h1 >= remaining) bin = 254 - 4 * l; else { c += h1; if (c + h2 >= remaining) bin = 253 - 4 * l; else { c += h2; bin = 252 - 4 * l; } } }
                sel[0] = prefix | ((unsigned)bin << shift); sel[1] = remaining - c;
            }
        }
        __syncthreads();
    }
    const unsigned T = sel[0], need_eq = sel[1], n_gt = (unsigned)CAP - need_eq;
    unsigned gt = 0, eq = 0;
    for (int i = 0; i < 32; ++i) { const unsigned k = keys[33 * tid + i]; gt += (k > T) ? 1u : 0u; eq += (k == T) ? 1u : 0u; }
    const unsigned packed = gt | (eq << 16);
    unsigned incl = packed;
#pragma unroll
    for (int o = 1; o < 64; o <<= 1) { const unsigned n = __shfl_up(incl, o); if (l >= o) incl += n; }
    if (l == 63) wtot[F.wave] = incl;
    __syncthreads();
    unsigned base = incl - packed;
    for (int w = 0; w < F.wave; ++w) base += wtot[w];
    unsigned gbase = base & 0xFFFFu, ebase = base >> 16;
    for (int i = 0; i < 32; ++i) {
        const int tok = 32 * tid + i; const unsigned k = keys[33 * tid + i]; int slot = -1;
        if (k > T) slot = (int)(gbase++);
        else if (k == T) { if (ebase < need_eq) slot = (int)(n_gt + ebase); ++ebase; }
        TOKSLOT[(size_t)tok * NE + e] = slot;
        if (slot >= 0) { IDX[e * CAP + slot] = tok; GATE[e * CAP + slot] = __uint_as_float(k); }
    }
    __syncthreads();
}
__device__ __forceinline__ void phase_gather(const Frame& F, const Args& a) {
    const int* IDX = (const int*)(a.ws + WS_SEL + SEL_IDX);
    const u32x4* XB8 = (const u32x4*)(a.ws + WS_XB); u32x4* XIN = (u32x4*)(a.ws + WS_SCR + SC_XIN);
    for (int r = F.gw; r < NE * CAP; r += F.NGW) {
        const int tok = IDX[r];
        const u32x4* src = XB8 + (size_t)tok * (DM / 16) + F.lane; u32x4* dst = XIN + (size_t)r * (DM / 16) + F.lane;
        const u32x4 v0 = src[0], v1 = src[64];
        dst[0] = v0; dst[64] = v1;
    }
}
__device__ __forceinline__ void phase_ln2(const Frame& F, const Args& a, int layer, float* OUT, bool write_xb) {
    const float* X1 = (const float*)(a.ws + WS_X1); const bf16_t* YS = (const bf16_t*)(a.ws + WS_SCR + SC_YS);
    const int* TOKSLOT = (const int*)(a.ws + WS_SEL + SEL_TOKSLOT); bf16_t* XB = (bf16_t*)(a.ws + WS_XB);
    const float* G = a.in[I_LNF_G] + layer * DM; const float* Bv = a.in[I_LNF_B] + layer * DM;
    const int l = F.lane;
    for (int t = F.gw; t < S; t += F.NGW) {
        const f32x4* xr = (const f32x4*)(X1 + (size_t)t * DM) + l;
        f32x4 v[8];
#pragma unroll
        for (int j = 0; j < 8; ++j) v[j] = xr[64 * j] * ALPHA;
        const int myslot = TOKSLOT[(size_t)t * NE + (l & 15)];
#define LN2_ACC(Y) do { _Pragma("unroll") for (int j = 0; j < 8; ++j) { const u32x2 y = (Y)[j]; v[j] = v[j] + (f32x4){__uint_as_float(y.x << 16), __uint_as_float(y.x & 0xffff0000u), __uint_as_float(y.y << 16), __uint_as_float(y.y & 0xffff0000u)}; } } while (0)
        unsigned act = (unsigned)(__ballot(myslot >= 0) & 0xFFFFull);
        while (act) {
            const int e0 = __builtin_ctz(act); act &= act - 1u;
            const u32x2* y0r = (const u32x2*)(YS + ((size_t)e0 * CAP + __shfl(myslot, e0)) * DM) + l;
            u32x2 ya[8];
#pragma unroll
            for (int j = 0; j < 8; ++j) ya[j] = y0r[64 * j];
            if (act) {
                const int e1 = __builtin_ctz(act); act &= act - 1u;
                const u32x2* y1r = (const u32x2*)(YS + ((size_t)e1 * CAP + __shfl(myslot, e1)) * DM) + l;
                u32x2 yb[8];
#pragma unroll
                for (int j = 0; j < 8; ++j) yb[j] = y1r[64 * j];
                LN2_ACC(ya); LN2_ACC(yb);
            } else { LN2_ACC(ya); }
        }
#undef LN2_ACC
        float s = 0.f;
#pragma unroll
        for (int j = 0; j < 8; ++j) s += (v[j].x + v[j].y) + (v[j].z + v[j].w);
        const float mean = wave_sum(s) * (1.f / DM); float s2 = 0.f;
#pragma unroll
        for (int j = 0; j < 8; ++j) { v[j] = v[j] - mean; s2 += (v[j].x * v[j].x + v[j].y * v[j].y) + (v[j].z * v[j].z + v[j].w * v[j].w); }
        const float rstd = 1.f / sqrtf(wave_sum(s2) * (1.f / DM) + LN_EPS);
        f32x4* orow = (f32x4*)(OUT + (size_t)t * DM) + l; u32x2* xb = (u32x2*)(XB + (size_t)t * DM) + l;
#pragma unroll
        for (int j = 0; j < 8; ++j) { const f32x4 g = *((const f32x4*)G + 64 * j + l), b = *((const f32x4*)Bv + 64 * j + l);
            const f32x4 o = v[j] * rstd * g + b; orow[64 * j] = o; if (write_xb) xb[64 * j] = (u32x2){pk2(o.x, o.y), pk2(o.z, o.w)}; }
    }
}
__device__ __forceinline__ void phase_prep1(const Frame& F, const Args& a) {
    const float* H1 = (const float*)(a.ws + WS_SCR + SC_H1);
    bf16_t* CQN = (bf16_t*)(a.ws + WS_SCR + SC_CQN); bf16_t* CKVN = (bf16_t*)(a.ws + WS_SCR + SC_CKVN); bf16_t* KROPE = (bf16_t*)(a.ws + WS_SCR + SC_KROPE);
    const f32x2* tab = (const f32x2*)(a.ws + WS_TAB);
    const int l = F.lane;
    for (int t = F.gw; t < S; t += F.NGW) {
        const float* hr = H1 + (size_t)t * MLA_IN_PAD;
#pragma unroll
        for (int part = 0; part < 2; ++part) {
            const f32x4 v0 = *((const f32x4*)(hr + part * 512) + l), v1 = *((const f32x4*)(hr + part * 512) + 64 + l);
            const float ss = wave_sum((v0.x * v0.x + v0.y * v0.y) + (v0.z * v0.z + v0.w * v0.w) + (v1.x * v1.x + v1.y * v1.y) + (v1.z * v1.z + v1.w * v1.w));
            const float r = 1.0f / sqrtf(ss * (1.f / 512) + NORM_EPS);
            const float* w = part == 0 ? a.in[I_M_QN] : a.in[I_M_KVN];
            const f32x4 g0 = *((const f32x4*)w + l), g1 = *((const f32x4*)w + 64 + l);
            bf16_t* dst = (part == 0 ? CQN : CKVN) + (size_t)t * 512;
            *((u32x2*)dst + l) = (u32x2){pk2(v0.x * r * g0.x, v0.y * r * g0.y), pk2(v0.z * r * g0.z, v0.w * r * g0.w)};
            *((u32x2*)dst + 64 + l) = (u32x2){pk2(v1.x * r * g1.x, v1.y * r * g1.y), pk2(v1.z * r * g1.z, v1.w * r * g1.w)};
        }
        const float y = hr[1024 + l];
        const float q = __shfl_xor(y, 16);
        const int half = l >> 5, ll = l & 31, i = ll & 15;
        const f32x2 cs = half == 0 ? tab[TAB_R64 + (t >> 6) * 16 + i] : tab[TAB_C64 + (t & 63) * 16 + i];
        const float o = ll < 16 ? y * cs.x - q * cs.y : y * cs.x + q * cs.y;
        KROPE[(size_t)t * 64 + l] = (bf16_t)f2bf(o);
    }
}
template <bool FIX>
__device__ __forceinline__ void phase_attn1(const Frame& F, const Args& a) {
    unsigned char* sc = a.ws + WS_SCR;
    const bf16_t* QM = (const bf16_t*)(sc + SC_QM); const bf16_t* KVM = (const bf16_t*)(sc + SC_KVM); const bf16_t* KROPE = (const bf16_t*)(sc + SC_KROPE);
    bf16_t* AO = (bf16_t*)(sc + SC_AO);
    const f32x2* tab = (const f32x2*)(a.ws + WS_TAB);
    constexpr int NU = 16 * 64;
    for (int u = blockIdx.x; u < NU; u += F.G) {
        const int h = u >> 6, qb = u & 63, q0 = qb * 256;
        att::attn_ring<192, false, true, 3072, 4096, 4096, DM, FIX>(QM + (size_t)q0 * 3072 + h * 192, KVM + h * 256, KVM + h * 256 + 128, KROPE,
                                                                     AO + (size_t)q0 * DM + h * 128, q0, 0, S / 64, F.ldsg, 0.f, tab + TAB_R64, tab + TAB_C64, (unsigned*)(a.ws + WS_CTL) + CW_AFLAG + 1);
        __syncthreads();
    }
}


#ifndef SYN_MODE
#define SYN_MODE 0
#endif
#if SYN_MODE
__device__ __forceinline__ void phase_syn(const Frame& F, const Args& a) {
    const float* xin = a.in[I_X];
    bf16x8 fa = *(const bf16x8*)(xin + F.tid * 8), fb = *(const bf16x8*)(xin + 4096 + F.tid * 8);
    f32x16 c0 = {}, c1 = {};
    float v[10];
#pragma unroll
    for (int i = 0; i < 10; ++i) v[i] = xin[8192 + F.tid + 512 * i];
    const float k1 = xin[1], k2 = xin[2];
    constexpr int T = 1000;
#if SYN_MODE == 5
    if (F.wave >= 4) { for (int t = 0; t < 8; ++t) { _Pragma("unroll") for (int i = 0; i < 10; ++i) asm volatile("v_fma_f32 %0, %0, %1, %2" : "+v"(v[i]) : "v"(k1), "v"(k2)); __builtin_amdgcn_sched_barrier(0); } }
#endif
    for (int t = 0; t < T; ++t) {
#pragma unroll
        for (int m = 0; m < 16; ++m) {
#if SYN_MODE == 1 || SYN_MODE == 3 || SYN_MODE == 5
            if (m & 1) c1 = __builtin_amdgcn_mfma_f32_32x32x16_bf16(fa, fb, c1, 0, 0, 0); else c0 = __builtin_amdgcn_mfma_f32_32x32x16_bf16(fa, fb, c0, 0, 0, 0);
#endif
#if SYN_MODE == 4
            if (m & 1) asm volatile("v_mfma_f32_32x32x16_bf16 %0, %1, %2, %0" : "+a"(c1) : "v"(fa), "v"(fb)); else asm volatile("v_mfma_f32_32x32x16_bf16 %0, %1, %2, %0" : "+a"(c0) : "v"(fa), "v"(fb));
#endif
#if SYN_MODE >= 2
#pragma unroll
            for (int i = 0; i < 5; ++i) asm volatile("v_fma_f32 %0, %0, %1, %2" : "+v"(v[(m * 5 + i) % 10]) : "v"(k1), "v"(k2));
#endif
            __builtin_amdgcn_sched_barrier(0);
        }
    }
    float sacc = 0.f;
#pragma unroll
    for (int i = 0; i < 10; ++i) sacc += v[i];
#pragma unroll
    for (int r = 0; r < 16; ++r) sacc += c0[r] + c1[r];
    ((float*)(a.ws + WS_END))[blockIdx.x * NTHR + F.tid] = sacc;
}
#endif
constexpr int N_PHASES = 23;
#ifndef PH_MASK
#define PH_MASK 0x1FFFF
#endif
#define IN(k) (((PH_MASK >> (k)) & 1) && lo <= (k) && (k) < hi)
#define INM(j) (((PH_MASK >> (6 + (j))) & 1) && lo <= (pb + (j)) && (pb + (j)) < hi)
#ifndef DUP_BARRIER
#define DUP_BARRIER 0
#endif
#define SEAM(k) do { if (lo <= (k) && (k) + 1 < hi) { xcd_barrier(bar); if (DUP_BARRIER) xcd_barrier(bar); } } while (0)
#ifndef DUP_SMALL
#define DUP_SMALL 0
#endif
#define DUPS(bit, stmt) do { if ((DUP_SMALL >> (bit)) & 1) { xcd_barrier(bar); stmt; } } while (0)

template <int LAYER>
__device__ __forceinline__ void run_layer(const Frame& F, const Args& args, const XcdBarrier& bar, const int lo, const int hi) {
    unsigned char* ws = args.ws; unsigned char* sc = ws + WS_SCR;
    if constexpr (LAYER == 0) {
        if (IN(1)) {
            pg8::Gemm g{(const bf16_t*)(ws + WS_XB), (const bf16_t*)(ws + WS_WIN), S, AB_IN, DM}; pg8::StaticOrder So; So.init(S, AB_IN, F.G, (int)blockIdx.x);
            pg8::EpiIn0 E{(float*)(sc + SC_HQK), (bf16_t*)(sc + SC_HB)};
            pg8::gemm_phase<pg8::EpiIn0, pg8::StaticOrder>(F.lds + RING_OFF, g, So, E); DUPS(7, (pg8::gemm_phase<pg8::EpiIn0, pg8::StaticOrder>(F.lds + RING_OFF, g, So, E))); SEAM(1);
        }
        if (IN(2)) { phase_prep0(F, args); DUPS(0, phase_prep0(F, args)); SEAM(2); }
        if (IN(3)) {
#ifndef FORCE_FALLBACK
#define FORCE_FALLBACK 0
#endif
            if ((int)blockIdx.x < N_CONV) { convert_experts(F, args); __syncthreads(); }
            phase_attn0<true>(F, args, 0); if (FORCE_FALLBACK && F.tid == 0) atomicOr((unsigned*)(args.ws + WS_CTL) + CW_AFLAG, 1u); xcd_barrier(bar);
            if (__hip_atomic_load((unsigned*)(args.ws + WS_CTL) + CW_AFLAG, __ATOMIC_RELAXED, __HIP_MEMORY_SCOPE_AGENT) != 0u) { phase_attn0<false>(F, args, 32); SEAM(3); }
            }
        if (IN(4)) { phase_combine(F, args); DUPS(1, phase_combine(F, args)); SEAM(4); }
        if (IN(5)) {
            pg8::Gemm g{(const bf16_t*)(sc + SC_CAT), (const bf16_t*)(ws + WS_WOUT), S, DM, DM}; pg8::StaticOrder So; So.init(S, DM, F.G, (int)blockIdx.x);
            pg8::EpiResid E{args.in[I_X], (float*)(ws + WS_X1)};
            pg8::gemm_phase<pg8::EpiResid, pg8::StaticOrder>(F.lds + RING_OFF, g, So, E); DUPS(8, (pg8::gemm_phase<pg8::EpiResid, pg8::StaticOrder>(F.lds + RING_OFF, g, So, E))); SEAM(5);
        }
    } else {
        if (IN(12)) {
            pg8::Gemm g{(const bf16_t*)(ws + WS_XB), (const bf16_t*)(ws + WS_WMIN), S, MLA_IN_PAD, DM}; pg8::StaticOrder So; So.init(S, MLA_IN_PAD, F.G, (int)blockIdx.x);
            pg8::EpiF32 E{(float*)(sc + SC_H1), MLA_IN_PAD};
            pg8::gemm_phase<pg8::EpiF32, pg8::StaticOrder>(F.lds + RING_OFF, g, So, E); DUPS(9, (pg8::gemm_phase<pg8::EpiF32, pg8::StaticOrder>(F.lds + RING_OFF, g, So, E))); SEAM(12);
        }
        if (IN(13)) { phase_prep1(F, args); DUPS(2, phase_prep1(F, args)); SEAM(13); }
        if (IN(14)) {
            static_assert(SC_CKVN == SC_CQN + (size_t)S * 512 * 2 && WS_WUKV == WS_WUQ + (size_t)3072 * 512 * 2, "the two up-projections' operands must be contiguous");
            pg8::Gemm g{(const bf16_t*)(sc + SC_CQN), (const bf16_t*)(ws + WS_WUQ), 2 * S, 7168, 512}; pg8::UpOrder So; So.init(F.G, (int)blockIdx.x);
            pg8::EpiUp E{(bf16_t*)(sc + SC_QM), (bf16_t*)(sc + SC_KVM)};
            pg8::gemm_phase<pg8::EpiUp, pg8::UpOrder>(F.lds + RING_OFF, g, So, E); DUPS(10, (pg8::gemm_phase<pg8::EpiUp, pg8::UpOrder>(F.lds + RING_OFF, g, So, E))); SEAM(14);
        }
#ifndef DUP_ATTN1
#define DUP_ATTN1 0
#endif
        if (IN(15)) {
            phase_attn1<true>(F, args); if (FORCE_FALLBACK && F.tid == 0) atomicOr((unsigned*)(args.ws + WS_CTL) + CW_AFLAG + 1, 1u); xcd_barrier(bar);
            if (__hip_atomic_load((unsigned*)(args.ws + WS_CTL) + CW_AFLAG + 1, __ATOMIC_RELAXED, __HIP_MEMORY_SCOPE_AGENT) != 0u) { phase_attn1<false>(F, args); SEAM(15); }
            }
        if (IN(16)) {
            pg8::Gemm g{(const bf16_t*)(sc + SC_AO), (const bf16_t*)(ws + WS_WMOUT), S, DM, DM}; pg8::StaticOrder So; So.init(S, DM, F.G, (int)blockIdx.x);
            pg8::EpiResid E{(const float*)(ws + WS_X2), (float*)(ws + WS_X1)};
            pg8::gemm_phase<pg8::EpiResid, pg8::StaticOrder>(F.lds + RING_OFF, g, So, E); DUPS(11, (pg8::gemm_phase<pg8::EpiResid, pg8::StaticOrder>(F.lds + RING_OFF, g, So, E))); SEAM(16);
        }
    }
    constexpr int pb = LAYER == 0 ? 6 : 17;
    if (INM(0)) { phase_ln_router(F, args, LAYER); SEAM(pb + 0); }
    if (INM(1)) { phase_topk(F, args); DUPS(3, phase_topk(F, args)); SEAM(pb + 1); }
    if (INM(3)) {
        pg8::Gemm g{(const bf16_t*)(ws + WS_XB), (const bf16_t*)((const unsigned char*)(ws + WS_WGU) + (size_t)LAYER * NE * 2 * FF * DM), NE * CAP, NE * 2 * FF, DM / 2, (const int*)(ws + WS_SEL + SEL_IDX)};
        pg8::GroupOrder So; So.init(16, F.G, (int)blockIdx.x);
        pg8::EpiSwiglu E{(unsigned char*)(sc + SC_HID)};
#ifndef DUP_GU
#define DUP_GU 0
#endif
        pg8::gemm_phase<pg8::EpiSwiglu, pg8::GroupOrder, true, true, true>(F.lds + RING_OFF, g, So, E);
        if (DUP_GU) { xcd_barrier(bar); pg8::gemm_phase<pg8::EpiSwiglu, pg8::GroupOrder, true, true, true>(F.lds + RING_OFF, g, So, E); }
        SEAM(pb + 3);
    }
    if (INM(4)) {
        pg8::Gemm g{(const bf16_t*)(sc + SC_HID), (const bf16_t*)((const unsigned char*)(ws + WS_WD) + (size_t)LAYER * NE * DM * FF), NE * CAP, NE * DM, FF / 2};
        pg8::GroupOrder So; So.init(8, F.G, (int)blockIdx.x);
        pg8::EpiDown E{(bf16_t*)(sc + SC_YS), (const float*)(ws + WS_SEL + SEL_GATE)};
        pg8::gemm_phase<pg8::EpiDown, pg8::GroupOrder, true, true>(F.lds + RING_OFF, g, So, E); DUPS(12, (pg8::gemm_phase<pg8::EpiDown, pg8::GroupOrder, true, true>(F.lds + RING_OFF, g, So, E))); SEAM(pb + 4);
    }
    if (INM(5)) { phase_ln2(F, args, LAYER, LAYER == 0 ? (float*)(ws + WS_X2) : args.out, LAYER == 0); DUPS(5, phase_ln2(F, args, LAYER, LAYER == 0 ? (float*)(ws + WS_X2) : args.out, LAYER == 0)); SEAM(pb + 5); }
}

__global__ void __launch_bounds__(NTHR, 2) mk_fwd(Args args) {
    extern __shared__ __attribute__((aligned(16))) unsigned char lds[];
    Frame F;
    F.lds = (LAS unsigned char*)lds; F.ldsg = (char*)lds;
    F.tid = threadIdx.x; F.lane = F.tid & 63; F.wave = __builtin_amdgcn_readfirstlane(F.tid >> 6);
    F.G = gridDim.x; F.gw = blockIdx.x * NWAVES + F.wave; F.NGW = F.G * NWAVES;
    volatile LAS unsigned* MISC = (volatile LAS unsigned*)(F.lds + MISC_OFF);
    for (int u = F.tid; u < (LDS_BYTES - LDSCTL_OFF) / 4; u += NTHR) ((LAS unsigned*)(F.lds + LDSCTL_OFF))[u] = 0u;
    __syncthreads();
    const int lo = args.ph_lo, hi = args.ph_hi;
    XcdBarrier bar = xcd_barrier_post((unsigned*)(args.ws + WS_CTL) + CW_BAR + lo * XCD_BAR_WORDS, MISC + 8);
#ifndef DUP_PROLOGUE
#define DUP_PROLOGUE 0
#endif
#if SYN_MODE
    if (IN(0)) { phase_syn(F, args); }
#endif
    if (IN(0)) { phase_prologue(F, args); if (DUP_PROLOGUE) { xcd_barrier(bar); phase_prologue(F, args); } SEAM(0); }
    run_layer<0>(F, args, bar, lo, hi);
    run_layer<1>(F, args, bar, lo, hi);
}
#undef IN
#undef INM
#undef SEAM

#ifdef SELFCHECK
constexpr size_t WS_CHK = 512 * 1024;
__device__ __forceinline__ unsigned hsh(unsigned x) { x ^= x >> 16; x *= 0x7feb352du; x ^= x >> 15; x *= 0x846ca68bu; x ^= x >> 16; return x; }
__device__ __forceinline__ float bfr(float x) { return bf2f((unsigned short)f2bf(x)); }
__device__ __forceinline__ void chk_commit(float* chk, int id, float err, float mag) {
    atomicMax((unsigned*)&chk[2 * id], __float_as_uint(err)); atomicMax((unsigned*)&chk[2 * id + 1], __float_as_uint(mag));
}
__device__ float blk_sum(float v, float* red) {
    v = wave_sum(v); __syncthreads(); if ((threadIdx.x & 63) == 0) red[threadIdx.x >> 6] = v; __syncthreads(); return red[0] + red[1] + red[2] + red[3];
}
__device__ float blk_max(float v, float* red) {
    v = wave_max(v); __syncthreads(); if ((threadIdx.x & 63) == 0) red[threadIdx.x >> 6] = v; __syncthreads(); return fmaxf(fmaxf(red[0], red[1]), fmaxf(red[2], red[3]));
}
__global__ void chk_gemm(int id, const bf16_t* A, const float* Af, int K, const float* W, int N, int n_lo, int n_hi, const float* outF, const bf16_t* outB, int ldo, int ocol0, const float* R, float* chk) {
    __shared__ float red[4];
    const unsigned hs = hsh(blockIdx.x * 977u + id * 131u + 7u);
    const int t = blockIdx.x == 0 ? 0 : (blockIdx.x == 1 ? S - 1 : (int)(hs % S)), n = n_lo + (int)(hsh(hs) % (unsigned)(n_hi - n_lo));
    float acc = 0.f;
    for (int k = threadIdx.x; k < K; k += 256) { const float a = Af ? bfr(Af[(size_t)t * K + k]) : bf2f(A[(size_t)t * K + k]); acc += a * bfr(W[(size_t)k * N + n]); }
    float ref = blk_sum(acc, red);
    if (threadIdx.x == 0) {
        float got = outF ? outF[(size_t)t * ldo + n - ocol0] : bf2f(outB[(size_t)t * ldo + n - ocol0]);
        if (R) got -= ALPHA * R[(size_t)t * DM + n];
        chk_commit(chk, id, fabsf(got - ref), fabsf(ref)); }
}
__device__ void rope_cs(int pos, int i, int n, float& c, float& s) { double f = 1.0; const double b = 0.7498942093324559; const int st = (n == 64) ? i : 2 * i; for (int j = 0; j < st; ++j) f *= b; double sn, cs; sincos_d((double)pos * f, sn, cs); c = (float)cs; s = (float)sn; }
__device__ float axial_rope_elem(const float* v, int D, int d, int t) {
    const int half = D / 2, hq = half / 2; const int blk = d / half, ld = d % half; const int pos = blk == 0 ? (t >> 6) : (t & 63);
    const int i = ld % hq; float c, s; rope_cs(pos, i, half, c, s);
    const float x1 = v[blk * half + i], x2 = v[blk * half + hq + i];
    return ld < hq ? x1 * c - x2 * s : x2 * c + x1 * s;
}
__global__ void chk_prep0(const float* HQK, const float* qn, const float* kn, const bf16_t* AQB, const bf16_t* AKB, float* chk) {
    __shared__ float red[4]; __shared__ float y[128];
    const unsigned hs = hsh(blockIdx.x * 7919u + 3u); const int t = blockIdx.x < 2 ? (blockIdx.x ? S - 1 : 0) : (int)(hs % S), hh = (int)(hsh(hs) % 10u);
    const int d = threadIdx.x & 127; const float v = HQK[(size_t)t * 1280 + hh * 128 + d];
    const float ss = blk_sum(threadIdx.x < 128 ? v * v : 0.f, red);
    if (threadIdx.x < 128) y[d] = v * (1.0f / sqrtf(ss / 128.f + NORM_EPS)) * (hh < 8 ? qn[d] : kn[d]);
    __syncthreads();
    float err = 0.f, mag = 0.f;
    if (threadIdx.x < 128) { const float ref = axial_rope_elem(y, 128, d, t); const float got = hh < 8 ? bf2f(AQB[(size_t)t * 1024 + hh * 128 + d]) : bf2f(AKB[(size_t)t * 256 + (hh - 8) * 128 + d]); err = fabsf(got - ref); mag = fabsf(ref); }
    err = blk_max(err, red); mag = blk_max(mag, red);
    if (threadIdx.x == 0) chk_commit(chk, 1, err, mag);
}
__global__ void chk_prep1(const float* H1, const float* qn, const float* kvn, const bf16_t* CQN, const bf16_t* CKVN, const bf16_t* KROPE, float* chk) {
    __shared__ float red[4]; __shared__ float kr[64];
    const unsigned hs = hsh(blockIdx.x * 7919u + 5u); const int t = blockIdx.x < 2 ? (blockIdx.x ? S - 1 : 0) : (int)(hs % S);
    const float* hr = H1 + (size_t)t * MLA_IN_PAD; float err = 0.f, mag = 0.f;
    for (int part = 0; part < 2; ++part) {
        const float a = hr[part * 512 + threadIdx.x], b = hr[part * 512 + 256 + threadIdx.x];
        const float ss = blk_sum(a * a + b * b, red); const float r = 1.0f / sqrtf(ss / 512.f + NORM_EPS);
        const float* w = part ? kvn : qn; const bf16_t* o = (part ? CKVN : CQN) + (size_t)t * 512;
        const float r0 = a * r * w[threadIdx.x], r1 = b * r * w[256 + threadIdx.x];
        err = fmaxf(err, fmaxf(fabsf(bf2f(o[threadIdx.x]) - r0), fabsf(bf2f(o[256 + threadIdx.x]) - r1))); mag = fmaxf(mag, fmaxf(fabsf(r0), fabsf(r1)));
    }
    if (threadIdx.x < 64) kr[threadIdx.x] = hr[1024 + threadIdx.x];
    __syncthreads();
    if (threadIdx.x < 64) { const float ref = axial_rope_elem(kr, 64, threadIdx.x, t); err = fmaxf(err, fabsf(bf2f(KROPE[(size_t)t * 64 + threadIdx.x]) - ref)); mag = fmaxf(mag, fabsf(ref)); }
    err = blk_max(err, red); mag = blk_max(mag, red);
    if (threadIdx.x == 0) chk_commit(chk, 5, err, mag);
}
template <int MODE>
__global__ void chk_attn(int id, const bf16_t* Q, const bf16_t* Kb, const bf16_t* Vb, const bf16_t* KR, const bf16_t* O, float* chk) {
    __shared__ float red[4]; __shared__ float q[192]; __shared__ float qt[64]; __shared__ float sc[S];
    constexpr int H = MODE == 0 ? 8 : 16, DQ = MODE == 0 ? 128 : 192;
    const unsigned hs = hsh(blockIdx.x * 104729u + id); const int t = blockIdx.x < 2 ? (blockIdx.x ? S - 1 : 0) : (int)(hs % S), h = (int)(hsh(hs) % (unsigned)H);
    const int ldq = MODE == 0 ? 1024 : 3072, ldk = MODE == 0 ? 256 : 4096, ldv = MODE == 0 ? HB_LD : 4096;
    const int qo = MODE == 0 ? h * 128 : h * 192, ko = MODE == 0 ? (h >> 2) * 128 : h * 256, vo = MODE == 0 ? (h >> 2) * 128 : h * 256 + 128;
    if (threadIdx.x < DQ) q[threadIdx.x] = bf2f(Q[(size_t)t * ldq + qo + threadIdx.x]);
    __syncthreads();
    if (MODE == 1) { if (threadIdx.x < 64) qt[threadIdx.x] = bfr(axial_rope_elem(q + 128, 64, threadIdx.x, t)); __syncthreads(); if (threadIdx.x < 64) q[128 + threadIdx.x] = qt[threadIdx.x]; __syncthreads(); }
    const float scale = MODE == 0 ? 0.08838834764831845f : 0.07216878364870322f;
    float mx = -3e38f;
    for (int j = threadIdx.x; j < S; j += 256) { float a = 0.f;
        for (int d = 0; d < 128; ++d) a += q[d] * bf2f(Kb[(size_t)j * ldk + ko + d]);
        if (MODE == 1) for (int d = 0; d < 64; ++d) a += q[128 + d] * bf2f(KR[(size_t)j * 64 + d]);
        a *= scale; sc[j] = a; mx = fmaxf(mx, a); }
    mx = blk_max(mx, red);
    float sm = 0.f;
    for (int j = threadIdx.x; j < S; j += 256) { const float p = expf(sc[j] - mx); sc[j] = p; sm += p; }
    sm = blk_sum(sm, red);
    float err = 0.f, mag = 0.f;
    if (threadIdx.x < 128) { float o = 0.f; for (int j = 0; j < S; ++j) o += sc[j] * bf2f(Vb[(size_t)j * ldv + vo + threadIdx.x]); o /= sm;
        err = fabsf(bf2f(O[(size_t)t * DM + h * 128 + threadIdx.x]) - o); mag = fabsf(o); }
    err = blk_max(err, red); mag = blk_max(mag, red);
    if (threadIdx.x == 0) chk_commit(chk, id, err, mag);
}
__global__ void chk_report(const float* chk, float* out) {
    if (threadIdx.x || blockIdx.x) return;
    const float tol[10] = {0.02f, 0.02f, 0.05f, 0.02f, 0.02f, 0.02f, 0.02f, 0.02f, 0.05f, 0.02f};
    for (int c = 0; c < 10; ++c) { const float err = chk[2 * c], mag = chk[2 * c + 1]; const float rel = mag > 0.f ? err / mag : 9.f;
        if (!(rel <= tol[c])) { int dg = 0; float r = rel; while (r < 1.f && dg < 9) { r *= 10.f; ++dg; } out[0] = (float)(10 * (c + 1) + dg) * 1000.f; return; } }
}
#endif
extern "C" void kernel_launch(void* const* d_in, const int* in_sizes, int n_in, void* d_out, int out_size, void* d_ws, size_t ws_size, hipStream_t stream) {
    static int grid = 0;
    if (grid == 0) {
        if (n_in != N_IN || in_sizes[0] != S * DM || out_size != S * DM || ws_size < WS_END + MiB) {
            fprintf(stderr, "kernel_launch: unexpected shapes: n_in %d in0 %d out %d ws %zu (need %zu)\n", n_in, n_in > 0 ? in_sizes[0] : -1, out_size, ws_size, (size_t)WS_END); grid = -1; return; }
        int dev = 0, cus = 0, per_cu = 0;
        if (hipGetDevice(&dev) != hipSuccess || hipDeviceGetAttribute(&cus, hipDeviceAttributeMultiprocessorCount, dev) != hipSuccess) { grid = -1; return; }
        if (hipFuncSetAttribute((const void*)mk_fwd, hipFuncAttributeMaxDynamicSharedMemorySize, LDS_BYTES) != hipSuccess) { fprintf(stderr, "kernel_launch: hipFuncSetAttribute failed\n"); grid = -1; return; }
        if (hipOccupancyMaxActiveBlocksPerMultiprocessor(&per_cu, (const void*)mk_fwd, NTHR, LDS_BYTES) != hipSuccess || per_cu < 1) { fprintf(stderr, "kernel_launch: occupancy query says %d\n", per_cu); }
        (void)hipGetLastError();
        grid = cus;
    }
    if (grid < 0) return;
    if (hipMemsetAsync((char*)d_ws + WS_CTL, 0, CTL_ZERO_BYTES, stream) != hipSuccess) return;
    Args a{};
    for (int i = 0; i < N_IN; ++i) a.in[i] = (const float*)d_in[i];
    a.out = (float*)d_out; a.ws = (unsigned char*)d_ws;
#ifdef SELFCHECK
    {
        unsigned char* ws = (unsigned char*)d_ws; unsigned char* sc = ws + WS_SCR; float* chk = (float*)(ws + WS_CHK);
        auto run = [&](int lo, int hi) { for (int p = lo; p < hi; ++p) { a.ph_lo = p; a.ph_hi = p + 1; hipLaunchKernelGGL(mk_fwd, dim3(grid), dim3(NTHR), LDS_BYTES, stream, a); } };
        run(0, 6);
        hipLaunchKernelGGL(chk_gemm, dim3(96), dim3(256), 0, stream, 0, (const bf16_t*)nullptr, a.in[I_X], DM, a.in[I_AB_WIN], AB_IN, 0, 1280, (const float*)(sc + SC_HQK), (const bf16_t*)nullptr, 1280, 0, (const float*)nullptr, chk);
        hipLaunchKernelGGL(chk_gemm, dim3(96), dim3(256), 0, stream, 3, (const bf16_t*)nullptr, a.in[I_X], DM, a.in[I_AB_WIN], AB_IN, 1280, AB_IN, (const float*)nullptr, (const bf16_t*)(sc + SC_HB), HB_LD, 1280, (const float*)nullptr, chk);
        hipLaunchKernelGGL(chk_prep0, dim3(96), dim3(256), 0, stream, (const float*)(sc + SC_HQK), a.in[I_AB_QN], a.in[I_AB_KN], (const bf16_t*)(sc + SC_AQB), (const bf16_t*)(sc + SC_AKB), chk);
        hipLaunchKernelGGL(chk_attn<0>, dim3(48), dim3(256), 0, stream, 2, (const bf16_t*)(sc + SC_AQB), (const bf16_t*)(sc + SC_AKB), (const bf16_t*)(sc + SC_HB), (const bf16_t*)nullptr, (const bf16_t*)(sc + SC_CAT), chk);
        run(6, 17);
        hipLaunchKernelGGL(chk_gemm, dim3(96), dim3(256), 0, stream, 4, (const bf16_t*)(ws + WS_XB), (const float*)nullptr, DM, a.in[I_M_WIN], 1088, 0, 1088, (const float*)(sc + SC_H1), (const bf16_t*)nullptr, MLA_IN_PAD, 0, (const float*)nullptr, chk);
        hipLaunchKernelGGL(chk_prep1, dim3(96), dim3(256), 0, stream, (const float*)(sc + SC_H1), a.in[I_M_QN], a.in[I_M_KVN], (const bf16_t*)(sc + SC_CQN), (const bf16_t*)(sc + SC_CKVN), (const bf16_t*)(sc + SC_KROPE), chk);
        hipLaunchKernelGGL(chk_gemm, dim3(96), dim3(256), 0, stream, 6, (const bf16_t*)(sc + SC_CQN), (const float*)nullptr, 512, a.in[I_M_WUQ], 3072, 0, 3072, (const float*)nullptr, (const bf16_t*)(sc + SC_QM), 3072, 0, (const float*)nullptr, chk);
        hipLaunchKernelGGL(chk_gemm, dim3(96), dim3(256), 0, stream, 7, (const bf16_t*)(sc + SC_CKVN), (const float*)nullptr, 512, a.in[I_M_WUKV], 4096, 0, 4096, (const float*)nullptr, (const bf16_t*)(sc + SC_KVM), 4096, 0, (const float*)nullptr, chk);
        hipLaunchKernelGGL(chk_attn<1>, dim3(48), dim3(256), 0, stream, 8, (const bf16_t*)(sc + SC_QM), (const bf16_t*)(sc + SC_KVM), (const bf16_t*)(sc + SC_KVM), (const bf16_t*)(sc + SC_KROPE), (const bf16_t*)(sc + SC_AO), chk);
        hipLaunchKernelGGL(chk_gemm, dim3(96), dim3(256), 0, stream, 9, (const bf16_t*)(sc + SC_AO), (const float*)nullptr, DM, a.in[I_M_WOUT], DM, 0, DM, (const float*)(ws + WS_X1), (const bf16_t*)nullptr, DM, 0, (const float*)(ws + WS_X2), chk);
        run(17, N_PHASES);
        hipLaunchKernelGGL(chk_report, dim3(1), dim3(64), 0, stream, (const float*)chk, (float*)d_out);
    }
#elif MK_ONE_LAUNCH
    a.ph_lo = 0; a.ph_hi = N_PHASES;
    hipLaunchKernelGGL(mk_fwd, dim3(grid), dim3(NTHR), LDS_BYTES, stream, a);
#else
    for (int p = 0; p < N_PHASES; ++p) { a.ph_lo = p; a.ph_hi = p + 1; hipLaunchKernelGGL(mk_fwd, dim3(grid), dim3(NTHR), LDS_BYTES, stream, a); }
#endif
    const hipError_t le = hipPeekAtLastError();
    if (le != hipSuccess) fprintf(stderr, "kernel_launch: launch failed: %s\n", hipGetErrorName(le));
}
```

```cpp
#include <hip/hip_runtime.h>
#include <cstdio>
#include <cstdint>

#ifndef MK_ONE_LAUNCH
#define MK_ONE_LAUNCH 1
#endif

#define GAS __attribute__((address_space(1)))
#define LAS __attribute__((address_space(3)))
typedef unsigned short bf16_t;
typedef short bf16x8 __attribute__((ext_vector_type(8)));
typedef short s16x4 __attribute__((ext_vector_type(4)));
typedef float f32x4 __attribute__((ext_vector_type(4)));
typedef float f32x2 __attribute__((ext_vector_type(2)));
typedef float f32x16 __attribute__((ext_vector_type(16)));
typedef unsigned u32x4 __attribute__((ext_vector_type(4)));
typedef unsigned u32x2 __attribute__((ext_vector_type(2)));
typedef int v8i_t __attribute__((ext_vector_type(8)));

constexpr int S = 16384, DM = 2048, GRIDW = 64;
constexpr int AB_IN = 4608, NE = 16, FF = 2048, CAP = 2048;
constexpr int MLA_IN_PAD = 1280;
constexpr float ALPHA = 1.4142135623730951f;
constexpr float NORM_EPS = 1e-6f, LN_EPS = 1e-5f;
constexpr int NWAVES = 8, NTHR = 512;

constexpr size_t MiB = 1u << 20;
constexpr size_t WS_CTL = 0, CTL_ZERO_BYTES = 1 * MiB;
constexpr size_t WS_TAB = 1 * MiB;
constexpr size_t WS_SEL = 2 * MiB;
constexpr size_t WS_WIN = 6 * MiB, WS_WOUT = 24 * MiB, WS_WMIN = 32 * MiB, WS_WUQ = 37 * MiB, WS_WUKV = 40 * MiB, WS_WMOUT = 44 * MiB;
constexpr size_t WS_WGU = 52 * MiB, WS_WD = 564 * MiB;
constexpr size_t WS_XB = 820 * MiB, WS_X1 = 884 * MiB, WS_X2 = 1012 * MiB, WS_SCR = 1140 * MiB, WS_END = 1652 * MiB;
constexpr size_t SC_HQK = 0, SC_HB = 80 * MiB, SC_AQB = 184 * MiB, SC_AKB = 216 * MiB, SC_DO = 224 * MiB, SC_CAT = 352 * MiB;
constexpr size_t SC_XIN = 0, SC_HID = 128 * MiB, SC_YS = 256 * MiB;
constexpr size_t SC_H1 = 0, SC_CQN = 80 * MiB, SC_CKVN = 96 * MiB, SC_KROPE = 112 * MiB, SC_QM = 114 * MiB, SC_KVM = 210 * MiB, SC_AO = 338 * MiB;
constexpr int HB_LD = 3328;
constexpr size_t SEL_IDX = 0, SEL_GATE = 128 * 1024, SEL_TOKSLOT = 256 * 1024, SEL_AFF = 256 * 1024 + 1 * MiB;
constexpr int TAB_R128 = 0, TAB_C128 = 256 * 32, TAB_R64 = TAB_C128 + 64 * 32, TAB_C64 = TAB_R64 + 256 * 16, TAB_N = TAB_C64 + 64 * 16;
constexpr int CW_BAR = 16384;
constexpr int CW_QHEAD0 = 8192, CW_NORM2 = 8256, CW_AFLAG = 8320;
constexpr int CW_QHEAD0_ = 0;

constexpr int RING_OFF = 0, RING_BYTES = 131072;
constexpr int LDSCTL_OFF = 161792, MISC_OFF = LDSCTL_OFF + 320;
constexpr int LDS_BYTES = 163840;

#define RLX_AGENT __ATOMIC_RELAXED, __HIP_MEMORY_SCOPE_AGENT
#define LDS_WAIT() asm volatile("s_waitcnt lgkmcnt(0)" ::: "memory")
#define VM_WAIT() asm volatile("s_waitcnt vmcnt(0)" ::: "memory")
__device__ __forceinline__ unsigned f2bf(float f) { unsigned u = __builtin_bit_cast(unsigned, f); return (u + 0x7fffu + ((u >> 16) & 1u)) >> 16; }
__device__ __forceinline__ unsigned pk2(float lo, float hi) { return f2bf(lo) | (f2bf(hi) << 16); }
__device__ __forceinline__ float bf2f(unsigned short b) { return __builtin_bit_cast(float, ((unsigned)b) << 16); }
__device__ __forceinline__ unsigned cvt_pk_bf16(float lo, float hi) { unsigned r; asm volatile("v_cvt_pk_bf16_f32 %0, %1, %2" : "=v"(r) : "v"(lo), "v"(hi)); return r; }
__device__ __forceinline__ float wave_sum(float v) {
#pragma unroll
    for (int o = 1; o < 64; o <<= 1) v += __shfl_xor(v, o);
    return v;
}
__device__ __forceinline__ float wave_max(float v) {
#pragma unroll
    for (int o = 1; o < 64; o <<= 1) v = fmaxf(v, __shfl_xor(v, o));
    return v;
}

__device__ __forceinline__ float clamp8(float x) { return fminf(fmaxf(x, -448.f), 448.f); }
__device__ __forceinline__ unsigned pk4_fp8(float a, float b, float c, float d) {
    int w = __builtin_amdgcn_cvt_pk_fp8_f32(clamp8(a), clamp8(b), 0, false); w = __builtin_amdgcn_cvt_pk_fp8_f32(clamp8(c), clamp8(d), w, true); return (unsigned)w; }
constexpr float W8_GU = 32.f, W8_D = 64.f;
#define XB_TMO      128
#define XB_XCNT(j)  (256  + 64 * (j))
#define XB_XSUB(j)  (1280 + 64 * (j))
#define XB_XGEN(j)  (2304 + 64 * (j))
#define XB_TOP      3328
#define XB_TOPGEN   3392
#define XCD_BAR_WORDS 3456
#define XB_SPIN_CAP (1u << 20)

__device__ __forceinline__ unsigned xb_ld(unsigned* p)              { return __hip_atomic_load(p, __ATOMIC_RELAXED, __HIP_MEMORY_SCOPE_AGENT); }
__device__ __forceinline__ unsigned xb_add(unsigned* p, unsigned v) { return __hip_atomic_fetch_add(p, v, __ATOMIC_RELAXED, __HIP_MEMORY_SCOPE_AGENT); }
__device__ __forceinline__ unsigned xb_xcc_id() { return (unsigned)__builtin_amdgcn_s_getreg((3 << 11) | 20) & 0xFu; }
#define XB_SPIN(cond, bar) do { unsigned _sp = 0; while (cond) { __builtin_amdgcn_s_sleep(1); \
    if ((++_sp & 255u) == 0u) { if (xb_ld(&(bar)[XB_TMO])) break; if (_sp > XB_SPIN_CAP) { atomicAdd(&(bar)[XB_TMO], 1u); break; } } } } while (0)

struct XcdBarrier { unsigned* bar; unsigned x; volatile LAS unsigned* st; };

__device__ __forceinline__ XcdBarrier xcd_barrier_post(unsigned* bar, volatile LAS unsigned* st) {
    XcdBarrier b; b.bar = bar; b.x = xb_xcc_id(); b.st = st;
    if (threadIdx.x == 0) (void)xb_add(&bar[XB_XCNT(b.x)], 1u);
    return b;
}
__device__ __forceinline__ void xcd_barrier_complete(unsigned* bar, unsigned x, unsigned& nloc, unsigned& nx) {
    const unsigned G = gridDim.x * gridDim.y * gridDim.z;
    unsigned sum, cnt, mine, sp = 0u;
    for (;;) {
        sum = 0u; cnt = 0u; mine = 0u;
#pragma unroll
        for (unsigned j = 0; j < 16; ++j) { const unsigned c = xb_ld(&bar[XB_XCNT(j)]); sum += c; cnt += (c > 0u) ? 1u : 0u; mine = (j == x) ? c : mine; }
        if (sum == G) break;
        __builtin_amdgcn_s_sleep(1);
        if ((++sp & 255u) == 0u) { if (xb_ld(&bar[XB_TMO])) break; if (sp > XB_SPIN_CAP) { atomicAdd(&bar[XB_TMO], 1u); break; } }
    }
    nloc = mine > 0u ? mine : 1u; nx = cnt > 0u ? cnt : 1u;
}
__device__ __forceinline__ void xcd_barrier(const XcdBarrier& b) {
    asm volatile("s_waitcnt vmcnt(0)" ::: "memory");
    __syncthreads();
    if (threadIdx.x == 0) {
        unsigned* bar = b.bar; unsigned bx = b.x;
        asm volatile("" : "+s"(bar), "+s"(bx));
        __builtin_amdgcn_s_waitcnt(0);
        unsigned nloc = b.st[0], nx = b.st[1];
        if (nloc == 0u) { xcd_barrier_complete(bar, bx, nloc, nx); b.st[0] = nloc; b.st[1] = nx; }
        const unsigned old = xb_add(&bar[XB_XSUB(bx)], 1u);
        const unsigned gen = old / nloc;
        if (old + 1u == (gen + 1u) * nloc) {
            __builtin_amdgcn_fence(__ATOMIC_RELEASE, "agent");
            asm volatile("s_waitcnt vmcnt(0)" ::: "memory");
            const unsigned og = xb_add(&bar[XB_TOP], 1u);
            const unsigned tg = og / nx;
            if (og + 1u == (tg + 1u) * nx) xb_add(&bar[XB_TOPGEN], 1u);
            else XB_SPIN(xb_ld(&bar[XB_TOPGEN]) == tg, bar);
            __builtin_amdgcn_fence(__ATOMIC_ACQUIRE, "agent");
            xb_add(&bar[XB_XGEN(bx)], 1u);
            asm volatile("s_waitcnt vmcnt(0)" ::: "memory");
        } else {
            XB_SPIN(xb_ld(&bar[XB_XGEN(bx)]) == gen, bar);
            __builtin_amdgcn_fence(__ATOMIC_ACQUIRE, "agent");
            asm volatile("s_waitcnt vmcnt(0)" ::: "memory");
        }
    }
    __syncthreads();
}

namespace pg8 {
constexpr int BM = 256, BK = 64, HALF = 128, HTB = HALF * BK * 2, STAGE_BYTES = 8 * HTB, NXCD = 8, WGM = 8;
__host__ __device__ __forceinline__ int lds_byte(int r, int c) { const int st = (r >> 4) * 2 + (c >> 5), rr = r & 15, cc = c & 31, ob = rr * 64 + cc * 2; return st * 1024 + (ob ^ (((ob >> 9) & 1) << 5)); }
__host__ __device__ __forceinline__ void stage_rc(int b, int& R, int& C) { const int st = b / 1024, sb = b % 1024, swz = sb ^ (((sb >> 9) & 1) << 5); R = (st >> 1) * 16 + swz / 64; C = (st & 1) * 32 + (swz % 64) / 2; }
__host__ __device__ __forceinline__ int perm32(int rho) { const int n = rho >> 4, i = rho & 15; return 8 * (i >> 2) + 4 * n + (i & 3); }

struct Unit { int pm, pn; };
struct Gemm { const bf16_t* A; const bf16_t* Bt; int M, N, K; const int* idx; };

struct StaticOrder {
    int nM, nN, nwg, G, c;
    __device__ void init(int M, int N, int G_, int c_) { nM = M / BM; nN = N / BM; nwg = nM * nN; G = G_; c = c_; }
    __device__ bool next(int i, Unit& u) const {
        const long L = (long)i * G + c; if (L >= nwg) return false;
        int wgid = (int)L; { const int q = nwg / NXCD, r = nwg % NXCD, xcd = wgid % NXCD, off = wgid / NXCD; wgid = (xcd < r ? xcd * (q + 1) : r * (q + 1) + (xcd - r) * q) + off; }
        const int nig = WGM * nN, gid = wgid / nig, fm = gid * WGM, gsz = (nM - fm) < WGM ? (nM - fm) : WGM;
        u.pm = fm + ((wgid % nig) % gsz); u.pn = (wgid % nig) / gsz; return true;
    }
    __device__ __forceinline__ void a_ready(const Unit&) const {}
    __device__ __forceinline__ void done(const Unit&) const {}
};
struct GroupOrder {
    int G, c, per_e, nnt;
    __device__ void init(int nnt_, int G_, int c_) { nnt = nnt_; per_e = 8 * nnt_; G = G_; c = c_; }
    __device__ bool next(int i, Unit& u) const {
        const long L = (long)i * G + c; if (L >= (long)NE * per_e) return false;
        const int e = (int)L / per_e, r = (int)L % per_e;
        u.pm = e * 8 + (r % 8); u.pn = e * nnt + (r / 8); return true;
    }
    __device__ __forceinline__ void a_ready(const Unit&) const {}
    __device__ __forceinline__ void done(const Unit&) const {}
};

struct EpiBf16 {
    static constexpr bool PERM = true, AFTER_DRAIN = false;
    bf16_t* O; int ldc;
    __device__ __forceinline__ void operator()(const f32x4 (&acc)[2][2][4][2], const Unit& u, int wr, int wc, int fr, int fq) const {
        const int row0 = u.pm * BM + wr * 64 + fr, col0 = u.pn * BM + wc * 32 + 8 * fq;
#pragma unroll
        for (int ai = 0; ai < 2; ++ai)
#pragma unroll
            for (int m = 0; m < 4; ++m) { bf16_t* rowp = O + (size_t)(row0 + ai * HALF + m * 16) * ldc + col0;
#pragma unroll
                for (int bj = 0; bj < 2; ++bj) { const f32x4 v0 = acc[ai][bj][m][0], v1 = acc[ai][bj][m][1];
                    u32x4 w; w.x = cvt_pk_bf16(v0[0], v0[1]); w.y = cvt_pk_bf16(v0[2], v0[3]); w.z = cvt_pk_bf16(v1[0], v1[1]); w.w = cvt_pk_bf16(v1[2], v1[3]);
                    *(u32x4*)(rowp + bj * HALF) = w; } }
    }
};
struct UpOrder {
    int G, c;
    __device__ void init(int G_, int c_) { G = G_; c = c_; }
    __device__ bool next(int i, Unit& u) const {
        const int L = i * G + c; if (L >= 1792) return false;
        if (L < 768) { u.pm = L & 63; u.pn = L >> 6; } else { const int r = L - 768; u.pm = 64 + (r & 63); u.pn = 12 + (r >> 6); }
        return true;
    }
    __device__ __forceinline__ void a_ready(const Unit&) const {}
    __device__ __forceinline__ void done(const Unit&) const {}
};
struct EpiUp {
    static constexpr bool PERM = true, AFTER_DRAIN = false;
    bf16_t* QM; bf16_t* KVM;
    __device__ __forceinline__ void operator()(const f32x4 (&acc)[2][2][4][2], const Unit& u, int wr, int wc, int fr, int fq) const {
        const bool isq = u.pn < 12;
        bf16_t* O = isq ? QM : KVM; const int ldc = isq ? 3072 : 4096;
        const int row0 = (isq ? u.pm : u.pm - 64) * BM + wr * 64 + fr, col0 = (isq ? u.pn : u.pn - 12) * BM + wc * 32 + 8 * fq;
#pragma unroll
        for (int ai = 0; ai < 2; ++ai)
#pragma unroll
            for (int m = 0; m < 4; ++m) { bf16_t* rowp = O + (size_t)(row0 + ai * HALF + m * 16) * ldc + col0;
#pragma unroll
                for (int bj = 0; bj < 2; ++bj) { const f32x4 v0 = acc[ai][bj][m][0], v1 = acc[ai][bj][m][1];
                    u32x4 w; w.x = cvt_pk_bf16(v0[0], v0[1]); w.y = cvt_pk_bf16(v0[2], v0[3]); w.z = cvt_pk_bf16(v1[0], v1[1]); w.w = cvt_pk_bf16(v1[2], v1[3]);
                    *(u32x4*)(rowp + bj * HALF) = w; } }
    }
};
struct EpiF32 {
    static constexpr bool PERM = true, AFTER_DRAIN = false;
    float* C; int ldc;
    __device__ __forceinline__ void operator()(const f32x4 (&acc)[2][2][4][2], const Unit& u, int wr, int wc, int fr, int fq) const {
        const int row0 = u.pm * BM + wr * 64 + fr, col0 = u.pn * BM + wc * 32 + 8 * fq;
#pragma unroll
        for (int ai = 0; ai < 2; ++ai)
#pragma unroll
            for (int m = 0; m < 4; ++m) { float* rowp = C + (size_t)(row0 + ai * HALF + m * 16) * ldc + col0;
#pragma unroll
                for (int bj = 0; bj < 2; ++bj) { *(f32x4*)(rowp + bj * HALF) = acc[ai][bj][m][0]; *(f32x4*)(rowp + bj * HALF + 4) = acc[ai][bj][m][1]; } }
    }
};
struct EpiIn0 {
    static constexpr bool PERM = true, AFTER_DRAIN = false;
    float* F; bf16_t* B;
    __device__ __forceinline__ void operator()(const f32x4 (&acc)[2][2][4][2], const Unit& u, int wr, int wc, int fr, int fq) const {
        const int row0 = u.pm * BM + wr * 64 + fr, c0 = wc * 32 + 8 * fq;
        if (u.pn < 5) {
#pragma unroll
            for (int ai = 0; ai < 2; ++ai)
#pragma unroll
                for (int m = 0; m < 4; ++m) { float* rowp = F + (size_t)(row0 + ai * HALF + m * 16) * 1280 + u.pn * BM + c0;
#pragma unroll
                    for (int bj = 0; bj < 2; ++bj) { *(f32x4*)(rowp + bj * HALF) = acc[ai][bj][m][0]; *(f32x4*)(rowp + bj * HALF + 4) = acc[ai][bj][m][1]; } }
        } else {
#pragma unroll
            for (int ai = 0; ai < 2; ++ai)
#pragma unroll
                for (int m = 0; m < 4; ++m) { bf16_t* rowp = B + (size_t)(row0 + ai * HALF + m * 16) * HB_LD + (u.pn * BM - 1280) + c0;
#pragma unroll
                    for (int bj = 0; bj < 2; ++bj) { const f32x4 v0 = acc[ai][bj][m][0], v1 = acc[ai][bj][m][1];
                        u32x4 w; w.x = cvt_pk_bf16(v0[0], v0[1]); w.y = cvt_pk_bf16(v0[2], v0[3]); w.z = cvt_pk_bf16(v1[0], v1[1]); w.w = cvt_pk_bf16(v1[2], v1[3]);
                        *(u32x4*)(rowp + bj * HALF) = w; } }
        }
    }
};
struct EpiResid {
    static constexpr bool PERM = true, AFTER_DRAIN = false;
    const float* R; float* Y;
    __device__ __forceinline__ void operator()(const f32x4 (&acc)[2][2][4][2], const Unit& u, int wr, int wc, int fr, int fq) const {
        const int row0 = u.pm * BM + wr * 64 + fr, col0 = u.pn * BM + wc * 32 + 8 * fq;
#pragma unroll
        for (int ai = 0; ai < 2; ++ai)
#pragma unroll
            for (int m = 0; m < 4; ++m) { const size_t off = (size_t)(row0 + ai * HALF + m * 16) * DM + col0;
#pragma unroll
                for (int bj = 0; bj < 2; ++bj) { const f32x4 r0 = *(const f32x4*)(R + off + bj * HALF), r1 = *(const f32x4*)(R + off + bj * HALF + 4);
                    *(f32x4*)(Y + off + bj * HALF) = r0 * ALPHA + acc[ai][bj][m][0]; *(f32x4*)(Y + off + bj * HALF + 4) = r1 * ALPHA + acc[ai][bj][m][1]; } }
    }
};
__device__ __forceinline__ float silu_mul(float g, float u) { return g * __builtin_amdgcn_rcpf(1.f + __builtin_amdgcn_exp2f(-1.4426950408889634f * g)) * u; }
struct EpiSwiglu {
    static constexpr bool PERM = true, AFTER_DRAIN = false;
    unsigned char* H;
    __device__ __forceinline__ void operator()(const f32x4 (&acc)[2][2][4][2], const Unit& u, int wr, int wc, int fr, int fq) const {
        const int row0 = u.pm * BM + wr * 64 + fr, col0 = (u.pn & 15) * HALF + wc * 32 + 8 * fq;
        constexpr float is = 1.f / W8_GU;
#pragma unroll
        for (int ai = 0; ai < 2; ++ai)
#pragma unroll
            for (int m = 0; m < 4; ++m) { unsigned char* p = H + (unsigned)((row0 + ai * HALF + m * 16) * FF + col0);
                const f32x4 g0 = acc[ai][0][m][0] * is, g1 = acc[ai][0][m][1] * is, u0 = acc[ai][1][m][0] * is, u1 = acc[ai][1][m][1] * is;
                u32x2 w; w.x = pk4_fp8(silu_mul(g0[0], u0[0]), silu_mul(g0[1], u0[1]), silu_mul(g0[2], u0[2]), silu_mul(g0[3], u0[3]));
                w.y = pk4_fp8(silu_mul(g1[0], u1[0]), silu_mul(g1[1], u1[1]), silu_mul(g1[2], u1[2]), silu_mul(g1[3], u1[3]));
                *(u32x2*)p = w; }
    }
};
struct EpiDown {
    static constexpr bool PERM = true, AFTER_DRAIN = false;
    bf16_t* Y; const float* gate;
    __device__ __forceinline__ void operator()(const f32x4 (&acc)[2][2][4][2], const Unit& u, int wr, int wc, int fr, int fq) const {
        const int row0 = u.pm * BM + wr * 64 + fr, col0 = (u.pn & 7) * BM + wc * 32 + 8 * fq;
#pragma unroll
        for (int ai = 0; ai < 2; ++ai)
#pragma unroll
            for (int m = 0; m < 4; ++m) { const int row = row0 + ai * HALF + m * 16; const float g = gate[row] * (1.f / W8_D); bf16_t* rowp = (bf16_t*)((char*)Y + (unsigned)(row * DM + col0) * 2u);
#pragma unroll
                for (int bj = 0; bj < 2; ++bj) { const f32x4 v0 = acc[ai][bj][m][0] * g, v1 = acc[ai][bj][m][1] * g;
                    u32x4 w; w.x = cvt_pk_bf16(v0[0], v0[1]); w.y = cvt_pk_bf16(v0[2], v0[3]); w.z = cvt_pk_bf16(v1[0], v1[1]); w.w = cvt_pk_bf16(v1[2], v1[3]);
                    *(u32x4*)(rowp + bj * HALF) = w; } }
    }
};

template <class Epi, class Sched, bool ALIGN_EPI = true, bool F8 = false, bool GATHER = false>
__device__ __forceinline__ void gemm_phase(LAS unsigned char* lds, const Gemm g, const Sched& S, const Epi& E) {
    const int tid = threadIdx.x, wid = __builtin_amdgcn_readfirstlane(tid >> 6), lane = tid & 63, wr = wid >> 2, wc = wid & 3, fr = lane & 15, fq = lane >> 4;
    const int K = g.K, nt = K / BK;
    unsigned voffA[2], voffB[2];
#pragma unroll
    for (int i = 0; i < 2; ++i) { int R, C; stage_rc(tid * 16 + i * 8192, R, C); const int Rb = Epi::PERM ? ((R & ~31) + perm32(R & 31)) : R;
        voffA[i] = (unsigned)(R * K + C) * 2u; voffB[i] = (unsigned)(Rb * K + C) * 2u; }
    const size_t kstep = (size_t)(BK * 2);
    const size_t hstep = (size_t)HALF * K * 2;
    const size_t tstep = 2 * hstep;
    const unsigned ldsw = (unsigned)wid * 1024u;
    const int aoff = lds_byte(wr * 64 + fr, fq * 8), boff = lds_byte(wc * 32 + fr, fq * 8);
#define PG8_SA(b, h) (((b) * 2 + (h)) * HTB)
#define PG8_SB(b, h) ((4 + (b) * 2 + (h)) * HTB)
#define PG8_STAGE(bufoff, gbase, voff) do { _Pragma("unroll") for (int _i = 0; _i < 2; ++_i) { \
        if constexpr (F8) { const unsigned long long gb_ = (unsigned long long)(uintptr_t)(gbase); const unsigned m0_ = (unsigned)(uintptr_t)(lds + (bufoff) + ldsw + _i * 8192); unsigned keep_; \
            asm volatile("s_mov_b32 %0, m0\n\ts_mov_b32 m0, %3\n\ts_nop 0\n\tglobal_load_lds_dwordx4 %1, %2\n\ts_mov_b32 m0, %0" : "=&s"(keep_) : "v"((voff)[_i]), "s"(gb_), "s"(m0_) : "memory"); } \
        else __builtin_amdgcn_global_load_lds((const unsigned*)((const char*)(gbase) + (voff)[_i]), (LAS unsigned*)(lds + (bufoff) + ldsw + _i * 8192), 16, 0, 0); } } while (0)
#define PG8_RD16(off) (*(const LAS u32x4*)(lds + (off)))
#define PG8_LDA(dst, b, h) do { if constexpr (F8) { _Pragma("unroll") for (int m = 0; m < 4; ++m) { const u32x4 lo_ = PG8_RD16(PG8_SA(b, h) + aoff + m * 2048), hi_ = PG8_RD16(PG8_SA(b, h) + aoff + m * 2048 + 1024); \
            dst##8[m] = (v8i_t){(int)lo_.x, (int)lo_.y, (int)lo_.z, (int)lo_.w, (int)hi_.x, (int)hi_.y, (int)hi_.z, (int)hi_.w}; } } \
        else { _Pragma("unroll") for (int m = 0; m < 4; ++m) _Pragma("unroll") for (int k = 0; k < 2; ++k) dst[m][k] = *(const LAS bf16x8*)(lds + PG8_SA(b, h) + aoff + m * 2048 + k * 1024); } } while (0)
#define PG8_LDB(dst, b, h) do { if constexpr (F8) { _Pragma("unroll") for (int n = 0; n < 2; ++n) { const u32x4 lo_ = PG8_RD16(PG8_SB(b, h) + boff + n * 2048), hi_ = PG8_RD16(PG8_SB(b, h) + boff + n * 2048 + 1024); \
            dst##8[n] = (v8i_t){(int)lo_.x, (int)lo_.y, (int)lo_.z, (int)lo_.w, (int)hi_.x, (int)hi_.y, (int)hi_.z, (int)hi_.w}; } } \
        else { _Pragma("unroll") for (int n = 0; n < 2; ++n) _Pragma("unroll") for (int k = 0; k < 2; ++k) dst[n][k] = *(const LAS bf16x8*)(lds + PG8_SB(b, h) + boff + n * 2048 + k * 1024); } } while (0)
#define PG8_MMA(ai, bj, At, Bt) do { __builtin_amdgcn_s_setprio(1); \
        if constexpr (F8) { _Pragma("unroll") for (int m = 0; m < 4; ++m) _Pragma("unroll") for (int n = 0; n < 2; ++n) \
            asm volatile("v_mfma_scale_f32_16x16x128_f8f6f4 %0, %1, %2, %0, %3, %3 op_sel_hi:[0,0,0]" : "+v"(acc[ai][bj][m][n]) : "v"(Bt##8[n]), "v"(At##8[m]), "v"(one8)); } \
        else { _Pragma("unroll") for (int m = 0; m < 4; ++m) _Pragma("unroll") for (int n = 0; n < 2; ++n) _Pragma("unroll") for (int k = 0; k < 2; ++k) \
            acc[ai][bj][m][n] = __builtin_amdgcn_mfma_f32_16x16x32_bf16(Bt[n][k], At[m][k], acc[ai][bj][m][n], 0, 0, 0); } \
        __builtin_amdgcn_s_setprio(0); } while (0)
#define PG8_WAIT_V(n) asm volatile("s_waitcnt vmcnt(" #n ")" ::: "memory")
#define PG8_WAIT_L(n) asm volatile("s_waitcnt lgkmcnt(" #n ")" ::: "memory")
#define PG8_BAR __builtin_amdgcn_s_barrier()
#define PG8_SCHED __builtin_amdgcn_sched_barrier(0)
    unsigned goffC[2][2] = {{0u, 0u}, {0u, 0u}}, goffN[2][2] = {{0u, 0u}, {0u, 0u}};
#define PG8_GOFF(dst, unit) do { _Pragma("unroll") for (int h_ = 0; h_ < 2; ++h_) _Pragma("unroll") for (int i_ = 0; i_ < 2; ++i_) { int R_, C_; stage_rc(tid * 16 + i_ * 8192, R_, C_); \
        dst[h_][i_] = (unsigned)g.idx[(unit).pm * BM + h_ * HALF + R_] * (unsigned)(K * 2) + (unsigned)(C_ * 2); } } while (0)
#define PG8_STAGEA(bufoff, ptr, h, nx) do { if constexpr (GATHER) { const unsigned gs_[2] = {(nx) ? goffN[h][0] : goffC[h][0], (nx) ? goffN[h][1] : goffC[h][1]}; PG8_STAGE(bufoff, ptr, gs_); } \
        else { PG8_STAGE(bufoff, (ptr) + (h) * hstep, voffA); } } while (0)
    Unit cur, nxt; int ui = 0;
    if (!S.next(0, cur)) return;
    f32x4 acc[2][2][4][2];
#pragma unroll
    for (int a = 0; a < 2; ++a)
#pragma unroll
        for (int b = 0; b < 2; ++b)
#pragma unroll
            for (int m = 0; m < 4; ++m)
#pragma unroll
                for (int n = 0; n < 2; ++n) acc[a][b][m][n] = (f32x4){0.f, 0.f, 0.f, 0.f};
    const int one8 = 0x7F7F7F7F;
    bf16x8 At[4][2], B0[2][2], B1[2][2]; v8i_t At8[4], B08[2], B18[2];
    const char* cA = GATHER ? (const char*)g.A : (const char*)g.A + (size_t)cur.pm * tstep; const char* cB = (const char*)g.Bt + (size_t)cur.pn * tstep;
    if constexpr (GATHER) PG8_GOFF(goffC, cur);
    S.a_ready(cur);
    PG8_STAGE(PG8_SB(0, 0), cB, voffB); PG8_STAGE(PG8_SB(0, 1), cB + hstep, voffB); PG8_STAGEA(PG8_SA(0, 0), cA, 0, false); PG8_STAGEA(PG8_SA(0, 1), cA, 1, false);
    if (wr == 1) PG8_BAR;
    PG8_WAIT_V(2); PG8_BAR;
    PG8_STAGE(PG8_SB(1, 0), cB + kstep, voffB); PG8_STAGEA(PG8_SA(1, 0), cA + kstep, 0, false); PG8_STAGE(PG8_SB(1, 1), cB + hstep + kstep, voffB);
    PG8_WAIT_V(6); PG8_BAR;
    for (;;) {
        const bool has_next = S.next(ui + 1, nxt);
        if constexpr (GATHER) { if (has_next) PG8_GOFF(goffN, nxt); else { goffN[0][0] = goffC[0][0]; goffN[0][1] = goffC[0][1]; goffN[1][0] = goffC[1][0]; goffN[1][1] = goffC[1][1]; } }
        const char* nA = GATHER ? (const char*)g.A : (has_next ? (const char*)g.A + (size_t)nxt.pm * tstep : cA); const char* nB = has_next ? (const char*)g.Bt + (size_t)nxt.pn * tstep : cB;
        for (int t = 0; t < nt; t += 2) {
            const bool last = (t == nt - 2);
            const char* a1 = cA + (size_t)(t + 1) * kstep;
            const char* a2 = last ? nA : cA + (size_t)(t + 2) * kstep; const char* b2 = last ? nB : cB + (size_t)(t + 2) * kstep;
            const char* a3 = a2 + kstep; const char* b3 = b2 + kstep;
            if (last && has_next) S.a_ready(nxt);
            PG8_LDB(B0, 0, 0); PG8_LDB(B1, 0, 1); PG8_SCHED; PG8_LDA(At, 0, 0); PG8_STAGEA(PG8_SA(1, 1), a1, 1, false);
            PG8_WAIT_V(8); PG8_WAIT_L(0); PG8_BAR; PG8_MMA(0, 0, At, B0); PG8_MMA(0, 1, At, B1); PG8_BAR; PG8_SCHED;
            PG8_LDA(At, 0, 1); PG8_STAGE(PG8_SB(0, 0), b2, voffB); PG8_STAGE(PG8_SB(0, 1), b2 + hstep, voffB); PG8_STAGEA(PG8_SA(0, 0), a2, 0, last);
            PG8_WAIT_V(8); PG8_WAIT_L(0); PG8_BAR; PG8_MMA(1, 0, At, B0); PG8_MMA(1, 1, At, B1); PG8_BAR; PG8_SCHED;
            PG8_LDB(B0, 1, 0); PG8_LDB(B1, 1, 1); PG8_SCHED; PG8_LDA(At, 1, 0); PG8_STAGEA(PG8_SA(0, 1), a2, 1, last);
            PG8_WAIT_V(8); PG8_WAIT_L(0); PG8_BAR; PG8_MMA(0, 0, At, B0); PG8_MMA(0, 1, At, B1); PG8_BAR; PG8_SCHED;
            PG8_LDA(At, 1, 1); PG8_STAGE(PG8_SB(1, 0), b3, voffB); PG8_STAGE(PG8_SB(1, 1), b3 + hstep, voffB); PG8_STAGEA(PG8_SA(1, 0), a3, 0, last);
            PG8_WAIT_V(8); PG8_WAIT_L(0); PG8_BAR; PG8_MMA(1, 0, At, B0); PG8_MMA(1, 1, At, B1); PG8_BAR; PG8_SCHED;
        }
        if constexpr (ALIGN_EPI) { if (wr == 0) PG8_BAR; }
        { int te_ = threadIdx.x; asm volatile("" : "+v"(te_));
          const int le_ = te_ & 63, we_ = __builtin_amdgcn_readfirstlane(te_ >> 6); E(acc, cur, we_ >> 2, we_ & 3, le_ & 15, le_ >> 4); } S.done(cur);
        if (!has_next) break;
#pragma unroll
        for (int a = 0; a < 2; ++a)
#pragma unroll
            for (int b = 0; b < 2; ++b)
#pragma unroll
                for (int m = 0; m < 4; ++m)
#pragma unroll
                    for (int n = 0; n < 2; ++n) acc[a][b][m][n] = (f32x4){0.f, 0.f, 0.f, 0.f};
        cur = nxt; cA = nA; cB = nB; ++ui;
        if constexpr (GATHER) { goffC[0][0] = goffN[0][0]; goffC[0][1] = goffN[0][1]; goffC[1][0] = goffN[1][0]; goffC[1][1] = goffN[1][1]; }
        if constexpr (ALIGN_EPI) { if (wr == 1) PG8_BAR; }
    }
    PG8_WAIT_V(0);
    if constexpr (!ALIGN_EPI) { if (wr == 0) PG8_BAR; }
    PG8_BAR;
#undef PG8_SA
#undef PG8_SB
#undef PG8_STAGE
#undef PG8_STAGEA
#undef PG8_GOFF
#undef PG8_LDA
#undef PG8_LDB
#undef PG8_MMA
#undef PG8_RD16
#undef PG8_WAIT_V
#undef PG8_WAIT_L
#undef PG8_BAR
#undef PG8_SCHED
}
}

__device__ __forceinline__ void glds16s(unsigned voff, const void* sbase, unsigned lds_dst) {
    unsigned keep; const unsigned long long sb = (unsigned long long)(uintptr_t)sbase;
    asm volatile("s_mov_b32 %0, m0\n\ts_mov_b32 m0, %3\n\ts_nop 0\n\tglobal_load_lds_dwordx4 %1, %2\n\ts_mov_b32 m0, %0" : "=&s"(keep) : "v"(voff), "s"(sb), "s"(lds_dst) : "memory");
}
__device__ __forceinline__ void glds16(const void* gsrc, unsigned lds_dst) {
    unsigned keep;
    asm volatile("s_mov_b32 %0, m0\n\ts_mov_b32 m0, %2\n\ts_nop 0\n\tglobal_load_lds_dwordx4 %1, off\n\ts_mov_b32 m0, %0" : "=&s"(keep) : "v"(gsrc), "s"(lds_dst) : "memory");
}
namespace att {
constexpr int NW = 8, QBLK = 32, KVBLK = 64;
constexpr float THR = 8.f;
constexpr int SHM_V = 16384, SHM_K = 16384, SHM_KR = 8192;
constexpr int OFF_V = 0, OFF_K = 2 * SHM_V, OFF_KR = OFF_K + 2 * SHM_K, OFF_WS = OFF_KR + 2 * SHM_KR, OFF_QR = OFF_WS + NW * 64 * 4, ATTN_LDS = OFF_QR + NW * 4096;
#define KSWZ(row, colB) ((row) * 256 + ((colB) ^ (((row) & 15) << 4)))
#define KSWZR(row, colB) ((row) * 256 + ((colB) ^ (((row) & 7) << 4)))
#define KRO(k, c) ((k) * 128 + ((((c) ^ ((k) >> 1)) & 7) << 4))
#define SBAR() __builtin_amdgcn_sched_barrier(0)
__device__ __forceinline__ int crow(int r, int hi) { return (r & 3) + 8 * (r >> 2) + 4 * hi; }
__device__ __forceinline__ bf16x8 ld8(const bf16_t* p) { return *reinterpret_cast<const bf16x8*>(p); }
template <int DQ> struct Sc { static constexpr float SCALE = DQ == 128 ? 0.08838834764831845f : 0.07216878364870322f; };

template <int DQ>
__device__ __forceinline__ void partialSM(f32x16& p0, f32x16& p1, float& m_reg, float& mn, float& alpha) {
  constexpr float SCALE = Sc<DQ>::SCALE, C = SCALE * 1.4426950408889634f;
  float pmax = p0[0];
#pragma unroll
  for (int r = 1; r < 16; ++r) pmax = fmaxf(pmax, p0[r]);
#pragma unroll
  for (int r = 0; r < 16; ++r) pmax = fmaxf(pmax, p1[r]);
  { auto rr = __builtin_amdgcn_permlane32_swap(__float_as_uint(pmax), __float_as_uint(pmax), false, false);
    pmax = fmaxf(__uint_as_float(rr[0]), __uint_as_float(rr[1])); }
  if (__builtin_expect(__all(pmax - m_reg <= THR / SCALE), 1)) { mn = m_reg; alpha = 1.f; }
  else { mn = fmaxf(m_reg, pmax); alpha = __builtin_amdgcn_exp2f((m_reg - mn) * C); m_reg = mn; }
  float mnC = -mn * C;
#pragma unroll
  for (int r = 0; r < 16; ++r) p0[r] = fmaf(p0[r], C, mnC);
#pragma unroll
  for (int r = 0; r < 16; ++r) p1[r] = fmaf(p1[r], C, mnC);
#pragma unroll
  for (int r = 0; r < 16; ++r) p0[r] = __builtin_amdgcn_exp2f(p0[r]);
}
__device__ __forceinline__ void finishSM(f32x16& p0, f32x16& p1, float alpha, float& l_reg, bf16x8& pa0, bf16x8& pa1, bf16x8& pa2, bf16x8& pa3) {
#pragma unroll
  for (int r = 0; r < 16; ++r) p1[r] = __builtin_amdgcn_exp2f(p1[r]);
  float ps = 0;
#pragma unroll
  for (int r = 0; r < 16; ++r) ps += p0[r];
#pragma unroll
  for (int r = 0; r < 16; ++r) ps += p1[r];
  { auto rr = __builtin_amdgcn_permlane32_swap(__float_as_uint(ps), __float_as_uint(ps), false, false);
    ps = __uint_as_float(rr[0]) + __uint_as_float(rr[1]); }
  l_reg = l_reg * alpha + ps;
#define PK4(P, BASE, OUT) do { unsigned a0 = cvt_pk_bf16(P[BASE + 0], P[BASE + 1]), a1 = cvt_pk_bf16(P[BASE + 2], P[BASE + 3]);   \
    unsigned b0 = cvt_pk_bf16(P[BASE + 4], P[BASE + 5]), b1 = cvt_pk_bf16(P[BASE + 6], P[BASE + 7]);                              \
    u32x4 w = {a0, a1, b0, b1}; OUT = *reinterpret_cast<bf16x8*>(&w); } while (0)
  PK4(p0, 0, pa0); PK4(p0, 8, pa1); PK4(p1, 0, pa2); PK4(p1, 8, pa3);
#undef PK4
}
template <int DQ>
__device__ __forceinline__ void qkt(f32x16& p0, f32x16& p1, const char* Ks, const char* KRs, const bf16x8* qr, const char* qrl, int r32, int hi) {
#pragma unroll
  for (int d0 = 0; d0 < 8; ++d0) { int cb = (d0 * 16 + hi * 8) * 2;
    bf16x8 b0 = *reinterpret_cast<const bf16x8*>(Ks + KSWZ(r32, cb));
    bf16x8 b1 = *reinterpret_cast<const bf16x8*>(Ks + KSWZ(32 + r32, cb));
    p0 = __builtin_amdgcn_mfma_f32_32x32x16_bf16(b0, qr[d0], p0, 0, 0, 0);
    p1 = __builtin_amdgcn_mfma_f32_32x32x16_bf16(b1, qr[d0], p1, 0, 0, 0); }
  if constexpr (DQ == 192) {
#pragma unroll
    for (int d0 = 0; d0 < 4; ++d0) { int cb = (d0 * 16 + hi * 8) * 2;
      bf16x8 b0 = *reinterpret_cast<const bf16x8*>(KRs + KSWZR(r32, cb));
      bf16x8 b1 = *reinterpret_cast<const bf16x8*>(KRs + KSWZR(r32, 128 + cb));
      bf16x8 q = *reinterpret_cast<const bf16x8*>(qrl + d0 * 1024);
      p0 = __builtin_amdgcn_mfma_f32_32x32x16_bf16(b0, q, p0, 0, 0, 0);
      p1 = __builtin_amdgcn_mfma_f32_32x32x16_bf16(b1, q, p1, 0, 0, 0); }
  }
}
__device__ __forceinline__ void alibi_init(f32x16& p0, f32x16& p1, float dq, float sig, int dw) {
  if (dw >= 63 || dw <= -31) {
    const float ss = dw >= 63 ? sig : -sig, base = -ss * dq;
#pragma unroll
    for (int r = 0; r < 16; ++r) { const float kr = (float)((r & 3) + 8 * (r >> 2)); p0[r] = fmaf(ss, kr, base); p1[r] = fmaf(ss, kr + 32.f, base); }
  } else {
#pragma unroll
    for (int r = 0; r < 16; ++r) { const float kr = (float)((r & 3) + 8 * (r >> 2)); p0[r] = -sig * fabsf(dq - kr); p1[r] = -sig * fabsf(dq - (kr + 32.f)); }
  }
}
__device__ __forceinline__ int v_st(int k, int c) { const int kk = (k & ~0xC) | ((k & 4) << 1) | ((k & 8) >> 1); return ((kk >> 3) * 4 + (c >> 5)) * 512 + ((kk & 7) * 32 + (c & 31)) * 2; }
__device__ __forceinline__ int v_rd_base(int lane) { return ((lane & 3) << 3) | (((lane >> 2) & 3) << 6) | (((lane >> 4) & 1) << 5) | (((lane >> 5) & 1) << 11); }
constexpr int v_rd_off(int d0, int ks, int half) { return d0 * 512 + ks * 4096 + half * 256; }
template <int OFF> __device__ __forceinline__ s16x4 tr_read(int vb) {
  s16x4 r; asm volatile("ds_read_b64_tr_b16 %0, %1 offset:%2" : "=&v"(r) : "v"(vb), "i"(OFF) : "memory"); return r;
}
template <int D0> __device__ __forceinline__ void pv_one(f32x16& od, int vb, bf16x8 pa0, bf16x8 pa1, bf16x8 pa2, bf16x8 pa3) {
  const s16x4 l0 = tr_read<v_rd_off(D0, 0, 0)>(vb), h0 = tr_read<v_rd_off(D0, 0, 1)>(vb), l1 = tr_read<v_rd_off(D0, 1, 0)>(vb), h1 = tr_read<v_rd_off(D0, 1, 1)>(vb);
  const s16x4 l2 = tr_read<v_rd_off(D0, 2, 0)>(vb), h2 = tr_read<v_rd_off(D0, 2, 1)>(vb), l3 = tr_read<v_rd_off(D0, 3, 0)>(vb), h3 = tr_read<v_rd_off(D0, 3, 1)>(vb);
  asm volatile("s_waitcnt lgkmcnt(0)" ::: "memory"); SBAR();
#define PK(L, H) (bf16x8){L[0], L[1], L[2], L[3], H[0], H[1], H[2], H[3]}
  od = __builtin_amdgcn_mfma_f32_32x32x16_bf16(pa0, PK(l0, h0), od, 0, 0, 0);
  od = __builtin_amdgcn_mfma_f32_32x32x16_bf16(pa1, PK(l1, h1), od, 0, 0, 0);
  od = __builtin_amdgcn_mfma_f32_32x32x16_bf16(pa2, PK(l2, h2), od, 0, 0, 0);
  od = __builtin_amdgcn_mfma_f32_32x32x16_bf16(pa3, PK(l3, h3), od, 0, 0, 0);
#undef PK
}
__device__ __forceinline__ void pv_d0(f32x16* o, int vb, bf16x8 pa0, bf16x8 pa1, bf16x8 pa2, bf16x8 pa3) {
  pv_one<0>(o[0], vb, pa0, pa1, pa2, pa3); pv_one<1>(o[1], vb, pa0, pa1, pa2, pa3); pv_one<2>(o[2], vb, pa0, pa1, pa2, pa3); pv_one<3>(o[3], vb, pa0, pa1, pa2, pa3);
}

template <int DQ, bool ALIBI, bool OBF, int LDQ, int LDK, int LDV, int LDO, int SDEPTH>
__device__ __forceinline__ void attn_body(const bf16_t* __restrict__ Qb, const bf16_t* __restrict__ Kh, const bf16_t* __restrict__ Vh, const bf16_t* __restrict__ KRh,
                                          void* __restrict__ Ob, int q0, int kt0, int NT, char* lds, float sig, const f32x2* csr, const f32x2* csc) {
  int tid = threadIdx.x; asm volatile("" : "+v"(tid));
  const int wid = __builtin_amdgcn_readfirstlane(tid >> 6), lane = tid & 63, r32 = lane & 31, hi = lane >> 5;
  char* V_lds = lds + OFF_V; char* K_lds = lds + OFF_K; char* KR_lds = lds + OFF_KR;
  float* ws = (float*)(lds + OFF_WS) + wid * 64; float* li_l = ws; float* al_l = ws + 32;
  float m_reg = -1e30f, l_reg = 0; f32x16 o[4] = {}; bf16x8 qr[8];
  char* qrl = lds + OFF_QR + wid * 4096 + lane * 16;
  const bf16_t* Qw = Qb + (long)(wid * QBLK + r32) * LDQ + hi * 8;
#pragma unroll
  for (int d0 = 0; d0 < 8; ++d0) qr[d0] = ld8(Qw + d0 * 16);
  if constexpr (DQ == 192) {
    const int tok = q0 + wid * QBLK + r32;
    const f32x2* tr = csr + (tok >> 6) * 16 + hi * 8; const f32x2* tc = csc + (tok & 63) * 16 + hi * 8;
    const bf16x8 a0 = ld8(Qw + 128), a1 = ld8(Qw + 144), b0 = ld8(Qw + 160), b1 = ld8(Qw + 176);
    unsigned wa[4], wb[4], wc_[4], wd[4];
#pragma unroll
    for (int e = 0; e < 8; e += 2) {
      const f32x2 c0 = tr[e], c1 = tr[e + 1], d0_ = tc[e], d1_ = tc[e + 1];
      const float x10 = bf2f((unsigned short)a0[e]), x11 = bf2f((unsigned short)a0[e + 1]), x20 = bf2f((unsigned short)a1[e]), x21 = bf2f((unsigned short)a1[e + 1]);
      wa[e >> 1] = cvt_pk_bf16(x10 * c0.x - x20 * c0.y, x11 * c1.x - x21 * c1.y);
      wb[e >> 1] = cvt_pk_bf16(x20 * c0.x + x10 * c0.y, x21 * c1.x + x11 * c1.y);
      const float y10 = bf2f((unsigned short)b0[e]), y11 = bf2f((unsigned short)b0[e + 1]), y20 = bf2f((unsigned short)b1[e]), y21 = bf2f((unsigned short)b1[e + 1]);
      wc_[e >> 1] = cvt_pk_bf16(y10 * d0_.x - y20 * d0_.y, y11 * d1_.x - y21 * d1_.y);
      wd[e >> 1] = cvt_pk_bf16(y20 * d0_.x + y10 * d0_.y, y21 * d1_.x + y11 * d1_.y);
    }
    *(u32x4*)(qrl) = (u32x4){wa[0], wa[1], wa[2], wa[3]};
    *(u32x4*)(qrl + 1024) = (u32x4){wb[0], wb[1], wb[2], wb[3]};
    *(u32x4*)(qrl + 2048) = (u32x4){wc_[0], wc_[1], wc_[2], wc_[3]};
    *(u32x4*)(qrl + 3072) = (u32x4){wd[0], wd[1], wd[2], wd[3]};
  }
  const int sr = tid >> 4, sc = (tid & 15) * 8, vst0 = v_st(sr, sc), vst1 = v_st(32 + sr, sc);
  const int krk = tid >> 3, krc = tid & 7, krst = KSWZR(krk & 31, (krk >> 5) * 128 + krc * 16);
  const int vb0 = (int)(uintptr_t)(LAS char*)V_lds + v_rd_base(lane);
  const int qw0 = q0 + wid * QBLK;
  const float dq0 = (float)(qw0 + r32 - 4 * hi);
  struct { bf16x8 vs0, vs1, ks0, ks1, kr; } sr_[SDEPTH];
  const unsigned voV0 = (unsigned)(sr * LDV + sc) * 2u, voV1 = voV0 + 32u * LDV * 2u, voK0 = (unsigned)(sr * LDK + sc) * 2u, voK1 = voK0 + 32u * LDK * 2u, voKR = (unsigned)(krk * 64 + krc * 8) * 2u;
#define SLOAD(i, k0) do { const char* Vt_ = (const char*)Vh + (size_t)(k0) * (LDV * 2); const char* Kt_ = (const char*)Kh + (size_t)(k0) * (LDK * 2); \
    sr_[i].vs0 = *(const bf16x8*)(Vt_ + voV0); sr_[i].vs1 = *(const bf16x8*)(Vt_ + voV1); \
    sr_[i].ks0 = *(const bf16x8*)(Kt_ + voK0); sr_[i].ks1 = *(const bf16x8*)(Kt_ + voK1); \
    if constexpr (DQ == 192) sr_[i].kr = *(const bf16x8*)((const char*)KRh + (size_t)(k0) * 128 + voKR); } while (0)
#define SWRITE(b, i) do { *(bf16x8*)(V_lds + (b) * SHM_V + vst0) = sr_[i].vs0;          \
    *(bf16x8*)(V_lds + (b) * SHM_V + vst1) = sr_[i].vs1; int kc = sc * 2;               \
    *(bf16x8*)(K_lds + (b) * SHM_K + KSWZ(sr, kc)) = sr_[i].ks0;                       \
    *(bf16x8*)(K_lds + (b) * SHM_K + KSWZ(32 + sr, kc)) = sr_[i].ks1;                  \
    if constexpr (DQ == 192) *(bf16x8*)(KR_lds + (b) * SHM_KR + krst) = sr_[i].kr; } while (0)
#define SWAIT() do { if constexpr (SDEPTH == 1) asm volatile("s_waitcnt vmcnt(0)" ::: "memory"); else if constexpr (DQ == 192) asm volatile("s_waitcnt vmcnt(5)" ::: "memory"); else asm volatile("s_waitcnt vmcnt(4)" ::: "memory"); } while (0)
#define RESC(a) do { if (__any((a) < 1.f)) { if (hi == 0) al_l[r32] = (a); asm volatile("s_waitcnt lgkmcnt(0)" ::: "memory"); \
    _Pragma("unroll") for (int d = 0; d < 4; ++d) _Pragma("unroll") for (int r = 0; r < 16; ++r) o[d][r] *= al_l[crow(r, hi)]; } } while (0)
#define PINIT(P0, P1, tj) do { if constexpr (ALIBI) { const int k0_ = (kt0 + (tj)) * KVBLK; alibi_init(P0, P1, dq0 - (float)k0_, sig, qw0 - k0_); } else { P0 = f32x16{}; P1 = f32x16{}; } } while (0)
  f32x16 pA0, pA1, pB0, pB1; float mnA, mnB, alA, alB; bf16x8 pa0, pa1, pa2, pa3;
  const int kb = kt0 * KVBLK;
  constexpr int SE = 0, SO = SDEPTH - 1;
  SLOAD(SE, kb); asm volatile("s_waitcnt vmcnt(0)" ::: "memory"); SWRITE(0, SE); __syncthreads();
  PINIT(pA0, pA1, 0); qkt<DQ>(pA0, pA1, K_lds, KR_lds, qr, qrl, r32, hi); partialSM<DQ>(pA0, pA1, m_reg, mnA, alA);
  SLOAD(SO, kb + KVBLK); if constexpr (SDEPTH == 2) { if (2 < NT) SLOAD(SE, kb + 2 * KVBLK); }
  SWAIT(); SWRITE(1, SO); __syncthreads();
  for (int j = 1; j + 1 < NT; j += 2) {
    SBAR(); PINIT(pB0, pB1, j); qkt<DQ>(pB0, pB1, K_lds + SHM_K, KR_lds + SHM_KR, qr, qrl, r32, hi);
    finishSM(pA0, pA1, alA, l_reg, pa0, pa1, pa2, pa3); SBAR();
    SLOAD(SO, kb + (j + SDEPTH) * KVBLK); SBAR();
    pv_d0(o, vb0, pa0, pa1, pa2, pa3); partialSM<DQ>(pB0, pB1, m_reg, mnB, alB);
    __syncthreads(); SWAIT(); SWRITE(0, SE);
    RESC(alB); __syncthreads();
    SBAR(); PINIT(pA0, pA1, j + 1); qkt<DQ>(pA0, pA1, K_lds, KR_lds, qr, qrl, r32, hi);
    finishSM(pB0, pB1, alB, l_reg, pa0, pa1, pa2, pa3); SBAR();
    if (SDEPTH == 1 || j + 3 < NT) SLOAD(SE, kb + (j + 1 + SDEPTH) * KVBLK); SBAR();
    pv_d0(o, vb0 + SHM_V, pa0, pa1, pa2, pa3); partialSM<DQ>(pA0, pA1, m_reg, mnA, alA);
    __syncthreads(); SWAIT(); SWRITE(1, SO);
    RESC(alA); __syncthreads();
  }
  SBAR(); PINIT(pB0, pB1, NT - 1); qkt<DQ>(pB0, pB1, K_lds + SHM_K, KR_lds + SHM_KR, qr, qrl, r32, hi);
  finishSM(pA0, pA1, alA, l_reg, pa0, pa1, pa2, pa3); SBAR();
  pv_d0(o, vb0, pa0, pa1, pa2, pa3); partialSM<DQ>(pB0, pB1, m_reg, mnB, alB);
  __syncthreads(); RESC(alB);
  finishSM(pB0, pB1, alB, l_reg, pa0, pa1, pa2, pa3); SBAR();
  pv_d0(o, vb0 + SHM_V, pa0, pa1, pa2, pa3);
  if (hi == 0) li_l[r32] = l_reg; asm volatile("s_waitcnt lgkmcnt(0)" ::: "memory");
  int lane_e = lane; asm volatile("" : "+v"(lane_e));
  const int r32e = lane_e & 31, hie = lane_e >> 5;
  float rli[16];
#pragma unroll
  for (int r = 0; r < 16; ++r) rli[r] = __builtin_amdgcn_rcpf(li_l[crow(r, hie)]);
  if constexpr (OBF) {
    bf16_t* Ow = (bf16_t*)Ob + (size_t)(wid * QBLK) * LDO + (unsigned)(4 * hie * LDO + r32e);
#pragma unroll
    for (int r = 0; r < 16; ++r) { const int orow = (r & 3) + 8 * (r >> 2);
#pragma unroll
      for (int d0 = 0; d0 < 4; ++d0) Ow[orow * LDO + d0 * 32] = (bf16_t)f2bf(o[d0][r] * rli[r]); }
  } else {
    float* Ow = (float*)Ob + (size_t)(wid * QBLK) * LDO + (unsigned)(4 * hie * LDO + r32e);
#pragma unroll
    for (int r = 0; r < 16; ++r) { const int orow = (r & 3) + 8 * (r >> 2);
#pragma unroll
      for (int d0 = 0; d0 < 4; ++d0) Ow[orow * LDO + d0 * 32] = o[d0][r] * rli[r]; }
  }
#undef SLOAD
#undef SWRITE
#undef SWAIT
#undef RESC
#undef PINIT
}
__device__ __forceinline__ unsigned cvt2(float lo, float hi) { typedef __bf16 b2_t __attribute__((ext_vector_type(2))); const f32x2 v = {lo, hi}; return __builtin_bit_cast(unsigned, __builtin_convertvector(v, b2_t)); }
template <int DQ>
__device__ __forceinline__ void partialSM_nb(f32x16& p0, f32x16& p1, float& m_reg, float& alpha) {
  constexpr float SCALE = Sc<DQ>::SCALE, C = SCALE * 1.4426950408889634f;
  float pmax = p0[0];
#pragma unroll
  for (int r = 1; r < 16; ++r) pmax = fmaxf(pmax, p0[r]);
#pragma unroll
  for (int r = 0; r < 16; ++r) pmax = fmaxf(pmax, p1[r]);
  { auto rr = __builtin_amdgcn_permlane32_swap(__float_as_uint(pmax), __float_as_uint(pmax), false, false);
    pmax = fmaxf(__uint_as_float(rr[0]), __uint_as_float(rr[1])); }
  const bool keep = __all(pmax - m_reg <= THR / SCALE);
  const float mn = keep ? m_reg : fmaxf(m_reg, pmax);
  alpha = __builtin_amdgcn_exp2f((m_reg - mn) * C);
  m_reg = mn;
  const float mnC = -mn * C;
#pragma unroll
  for (int r = 0; r < 16; ++r) p0[r] = fmaf(p0[r], C, mnC);
#pragma unroll
  for (int r = 0; r < 16; ++r) p1[r] = fmaf(p1[r], C, mnC);
#pragma unroll
  for (int r = 0; r < 16; ++r) p0[r] = __builtin_amdgcn_exp2f(p0[r]);
}
__device__ __forceinline__ void finishSM_nb(f32x16& p0, f32x16& p1, float alpha, float& l_reg, bf16x8& pa0, bf16x8& pa1, bf16x8& pa2, bf16x8& pa3) {
#pragma unroll
  for (int r = 0; r < 16; ++r) p1[r] = __builtin_amdgcn_exp2f(p1[r]);
  float ps = 0;
#pragma unroll
  for (int r = 0; r < 16; ++r) ps += p0[r];
#pragma unroll
  for (int r = 0; r < 16; ++r) ps += p1[r];
  { auto rr = __builtin_amdgcn_permlane32_swap(__float_as_uint(ps), __float_as_uint(ps), false, false);
    ps = __uint_as_float(rr[0]) + __uint_as_float(rr[1]); }
  l_reg = l_reg * alpha + ps;
#define PK4(P, BASE, OUT) do { unsigned a0 = cvt2(P[BASE + 0], P[BASE + 1]), a1 = cvt2(P[BASE + 2], P[BASE + 3]);   \
    unsigned b0 = cvt2(P[BASE + 4], P[BASE + 5]), b1 = cvt2(P[BASE + 6], P[BASE + 7]);                              \
    u32x4 w = {a0, a1, b0, b1}; OUT = *reinterpret_cast<bf16x8*>(&w); } while (0)
  PK4(p0, 0, pa0); PK4(p0, 8, pa1); PK4(p1, 0, pa2); PK4(p1, 8, pa3);
#undef PK4
}
#ifndef SGB_ON
#define SGB_ON 1
#endif
#define SGB(mask, n) do { if (SGB_ON) __builtin_amdgcn_sched_group_barrier(mask, n, 0); } while (0)
template <int DQ, int VPM>
__device__ __forceinline__ void qkt_pipe(f32x16& p0, f32x16& p1, const LAS char* kp, const LAS char* krp, const bf16x8* qr, const LAS char* qrl, int r32, int hi) {
#ifndef QK_AH
#define QK_AH 2
#endif
  constexpr int NP = DQ / 16, AH = QK_AH;
  bf16x8 fa[NP], fb[NP], fq[NP > 8 ? NP - 8 : 1];
#define RD_PAIR(i) do { if ((i) < 8) { const int a_ = KSWZ(r32, ((i) * 16 + hi * 8) * 2); fa[i] = *(const LAS bf16x8*)(kp + a_); fb[i] = *(const LAS bf16x8*)(kp + a_ + 8192); } \
    else { const int a_ = KRO(r32, 2 * ((i) - 8) + hi); fa[i] = *(const LAS bf16x8*)(krp + a_); fb[i] = *(const LAS bf16x8*)(krp + a_ + 4096); fq[(i) < 8 ? 0 : (i) - 8] = *(const LAS bf16x8*)(qrl + ((i) - 8) * 1024); } } while (0)
#pragma unroll
  for (int i = 0; i < AH; ++i) RD_PAIR(i);
  SGB(0x100, 2 * AH);
#pragma unroll
  for (int i = 0; i < NP; ++i) {
    const bf16x8 q = i < 8 ? qr[i < 8 ? i : 0] : fq[i < 8 ? 0 : i - 8];
    p0 = __builtin_amdgcn_mfma_f32_32x32x16_bf16(fa[i], q, p0, 0, 0, 0); SGB(0x008, 1); SGB(0x002, VPM);
    if (i + AH < NP) { RD_PAIR(i + AH); if (i + AH < 8) SGB(0x100, 2); else SGB(0x100, 3); }
    p1 = __builtin_amdgcn_mfma_f32_32x32x16_bf16(fb[i], q, p1, 0, 0, 0); SGB(0x008, 1); SGB(0x002, VPM);
  }
#undef RD_PAIR
}
template <int VPM>
__device__ __forceinline__ void pv_pipe(f32x16* o, int vb, bf16x8 pa0, bf16x8 pa1, bf16x8 pa2, bf16x8 pa3) {
#define TR(off) __builtin_amdgcn_ds_read_tr16_b64_v4i16((LAS s16x4*)(uintptr_t)(unsigned)(vb + (off)))
#define PK(L, H) (bf16x8){L[0], L[1], L[2], L[3], H[0], H[1], H[2], H[3]}
  s16x4 lo[4][4], hh[4][4];
#pragma unroll
  for (int k = 0; k < 4; ++k) { lo[0][k] = TR(v_rd_off(0, k, 0)); hh[0][k] = TR(v_rd_off(0, k, 1)); }
  SGB(0x100, 8);
  const bf16x8 pa[4] = {pa0, pa1, pa2, pa3};
#pragma unroll
  for (int d0 = 0; d0 < 4; ++d0)
#pragma unroll
    for (int k = 0; k < 4; ++k) {
      o[d0] = __builtin_amdgcn_mfma_f32_32x32x16_bf16(pa[k], PK(lo[d0][k], hh[d0][k]), o[d0], 0, 0, 0); SGB(0x008, 1); SGB(0x002, VPM);
      if (d0 < 3) { lo[d0 + 1][k] = TR(v_rd_off(d0 + 1, k, 0)); hh[d0 + 1][k] = TR(v_rd_off(d0 + 1, k, 1)); SGB(0x100, 2); }
    }
#undef TR
#undef PK
}

__device__ __forceinline__ float vmax3(float a, float b, float c) { float r; asm("v_max3_f32 %0, %1, %2, %3" : "=v"(r) : "v"(a), "v"(b), "v"(c)); return r; }
__device__ __forceinline__ float vmax2(float a, float b) { float r; asm("v_max_f32 %0, %1, %2" : "=v"(r) : "v"(a), "v"(b)); return r; }
__device__ __forceinline__ bf16x8 scale_frag(bf16x8 v, float c) {
  u32x4 w;
  w.x = cvt2(bf2f((unsigned short)v[0]) * c, bf2f((unsigned short)v[1]) * c); w.y = cvt2(bf2f((unsigned short)v[2]) * c, bf2f((unsigned short)v[3]) * c);
  w.z = cvt2(bf2f((unsigned short)v[4]) * c, bf2f((unsigned short)v[5]) * c); w.w = cvt2(bf2f((unsigned short)v[6]) * c, bf2f((unsigned short)v[7]) * c);
  return *reinterpret_cast<bf16x8*>(&w);
}
__device__ __forceinline__ void finishSM_noexp(const f32x16& p0, const f32x16& p1, float& l_reg, bf16x8& pa0, bf16x8& pa1, bf16x8& pa2, bf16x8& pa3) {
  float s0 = 0.f, s1 = 0.f, s2 = 0.f, s3 = 0.f;
#pragma unroll
  for (int r = 0; r < 16; r += 2) { s0 += p0[r]; s1 += p0[r + 1]; s2 += p1[r]; s3 += p1[r + 1]; }
  float ps = (s0 + s1) + (s2 + s3);
  { auto rr = __builtin_amdgcn_permlane32_swap(__float_as_uint(ps), __float_as_uint(ps), false, false); ps = __uint_as_float(rr[0]) + __uint_as_float(rr[1]); }
  l_reg += ps;
#define PK4(P, BASE, OUT) do { unsigned a0 = cvt2(P[BASE + 0], P[BASE + 1]), a1 = cvt2(P[BASE + 2], P[BASE + 3]), b0 = cvt2(P[BASE + 4], P[BASE + 5]), b1 = cvt2(P[BASE + 6], P[BASE + 7]); \
    u32x4 w = {a0, a1, b0, b1}; OUT = *reinterpret_cast<bf16x8*>(&w); } while (0)
  PK4(p0, 0, pa0); PK4(p0, 8, pa1); PK4(p1, 0, pa2); PK4(p1, 8, pa3);
#undef PK4
}
struct FinState { float ps0, ps1; unsigned c[16]; };
#ifndef PROBE_GQA
#define PROBE_GQA 0
#endif
template <int W, int PRB, bool FIX>
__device__ __forceinline__ void fin_slot(f32x16& p0, f32x16& p1, FinState& st, bf16x8& pa0, bf16x8& pa1, bf16x8& pa2, bf16x8& pa3) {
  if constexpr (!(PRB & 1) && !FIX) p1[W] = __builtin_amdgcn_exp2f(p1[W]);
  st.ps0 += p0[W]; st.ps1 += p1[W];
  if constexpr (W < 8) st.c[W] = cvt2(p0[2 * W], p0[2 * W + 1]); else st.c[W] = cvt2(p1[2 * (W - 8)], p1[2 * (W - 8) + 1]);
  if constexpr ((W & 3) == 3) { constexpr int m = W >> 2;
    u32x4 w;
    w = (u32x4){st.c[4 * m], st.c[4 * m + 1], st.c[4 * m + 2], st.c[4 * m + 3]}; const bf16x8 v = *reinterpret_cast<bf16x8*>(&w);
    if constexpr (m == 0) pa0 = v; else if constexpr (m == 1) pa1 = v; else if constexpr (m == 2) pa2 = v; else pa3 = v; }
}
template <int DQ, int PRB, bool FIX, int KOFF, int KROFF = 0>
__device__ __forceinline__ void region1(f32x16& p0, f32x16& p1, const int kro, const int krro, const bf16x8* qr, const LAS char* qrl, int* ka, int r32, int hi,
                                        f32x16& q0_, f32x16& q1_, float alpha, float& l_reg, bf16x8& pa0, bf16x8& pa1, bf16x8& pa2, bf16x8& pa3) {
  constexpr int NP = DQ / 16, AH = 2;
  bf16x8 fa[NP], fb[NP], fq[NP > 8 ? NP - 8 : 1];
  FinState st; st.ps0 = 0.f; st.ps1 = 0.f;
#pragma unroll
  for (int i = 0; i < (DQ == 192 ? 12 : 8); ++i) asm volatile("" : "+v"(ka[i]));
#define KLD(addr) (*(const LAS bf16x8*)(uintptr_t)(unsigned)(addr))
#define RD_PAIR(i) do { if ((PRB & 4) && (i) > 0) { fa[i] = fa[0]; fb[i] = fb[0]; } else if ((i) < 8) { const int a_ = ka[(i) < 8 ? (i) : 0] + kro; fa[i] = KLD(a_ + KOFF); fb[i] = KLD(a_ + (KOFF + 8192)); } \
    else { const int a_ = ka[(i) >= 8 ? (i) : 8] + krro; fa[i] = KLD(a_ + KROFF); fb[i] = KLD(a_ + (KROFF + 4096)); fq[(i) < 8 ? 0 : (i) - 8] = *(const LAS bf16x8*)(qrl + ((i) - 8) * 1024); } } while (0)
#define FIN(slot) do { constexpr int s_ = (slot); if constexpr (PRB & (2 | 16)) {} else if constexpr (NP == 8) fin_slot<s_, PRB, FIX>(q0_, q1_, st, pa0, pa1, pa2, pa3); \
    else if constexpr (s_ % 3 != 2) fin_slot<s_ - s_ / 3, PRB, FIX>(q0_, q1_, st, pa0, pa1, pa2, pa3); } while (0)
#pragma unroll
  for (int i = 0; i < AH; ++i) RD_PAIR(i);
  SBAR();
#define R1_PAIR(i) do { const bf16x8 q = (i) < 8 ? qr[(i) < 8 ? (i) : 0] : fq[(i) < 8 ? 0 : (i) - 8]; \
    if constexpr (!(PRB & 8)) p0 = __builtin_amdgcn_mfma_f32_32x32x16_bf16(fa[i], q, p0, 0, 0, 0); else p0[i] += __builtin_bit_cast(float, fa[i][0] | (q[0] << 16)); FIN(2 * (i)); if ((i) + AH < NP) RD_PAIR((i) + AH); SBAR(); \
    if constexpr (!(PRB & 8)) p1 = __builtin_amdgcn_mfma_f32_32x32x16_bf16(fb[i], q, p1, 0, 0, 0); else p1[i] += __builtin_bit_cast(float, fb[i][0] | (q[1] << 16)); FIN(2 * (i) + 1); SBAR(); } while (0)
  R1_PAIR(0); R1_PAIR(1); R1_PAIR(2); R1_PAIR(3); R1_PAIR(4); R1_PAIR(5); R1_PAIR(6); R1_PAIR(7);
  if constexpr (NP == 12) { R1_PAIR(8); R1_PAIR(9); R1_PAIR(10); R1_PAIR(11); }
#undef R1_PAIR
#undef FIN
#undef RD_PAIR
#undef KLD
  float ps = st.ps0 + st.ps1;
  { auto rr = __builtin_amdgcn_permlane32_swap(__float_as_uint(ps), __float_as_uint(ps), false, false);
    ps = __uint_as_float(rr[0]) + __uint_as_float(rr[1]); }
  l_reg = l_reg * alpha + ps;
}
template <int DQ, int PRB, bool FIX>
__device__ __forceinline__ void region2(f32x16* o, int vb, bf16x8 pa0, bf16x8 pa1, bf16x8 pa2, bf16x8 pa3, f32x16& p0, f32x16& p1, float& m_reg, float& alpha) {
  constexpr float SCALE = Sc<DQ>::SCALE, C = SCALE * 1.4426950408889634f;
#define TR(off) __builtin_amdgcn_ds_read_tr16_b64_v4i16((LAS s16x4*)(uintptr_t)(unsigned)(vb + (off)))
#define PK(L, H) (bf16x8){L[0], L[1], L[2], L[3], H[0], H[1], H[2], H[3]}
  s16x4 lo[4][4], hh[4][4];
#pragma unroll
  for (int k = 0; k < 4; ++k) { lo[0][k] = TR(v_rd_off(0, k, 0)); hh[0][k] = TR(v_rd_off(0, k, 1)); }
  SBAR();
  const bf16x8 pa[4] = {pa0, pa1, pa2, pa3};
  float t0, t1, t2, t3, mnC = 0.f;
#define PEXP(x) ((PRB & 1) ? (x) : __builtin_amdgcn_exp2f(x))
#define SM_SLOT(sl) do { constexpr int s_ = (sl); if constexpr (PRB & (2 | 32)) {} else if constexpr (FIX) { p0[s_] = __builtin_amdgcn_exp2f(p0[s_]); p1[s_] = __builtin_amdgcn_exp2f(p1[s_]); if constexpr (s_ == 0) alpha = 1.f; } else { \
    if constexpr (s_ == 0) { t0 = vmax2(vmax3(vmax3(vmax3(p0[0], p0[1], p0[2]), p0[3], p0[4]), p0[5], p0[6]), p0[7]); } \
    if constexpr (s_ == 1) { t1 = vmax2(vmax3(vmax3(vmax3(p0[8], p0[9], p0[10]), p0[11], p0[12]), p0[13], p0[14]), p0[15]); } \
    if constexpr (s_ == 2) { t2 = vmax2(vmax3(vmax3(vmax3(p1[0], p1[1], p1[2]), p1[3], p1[4]), p1[5], p1[6]), p1[7]); } \
    if constexpr (s_ == 3) { t3 = vmax2(vmax3(vmax3(vmax3(p1[8], p1[9], p1[10]), p1[11], p1[12]), p1[13], p1[14]), p1[15]); } \
    if constexpr (s_ == 4) { float pmax = vmax2(vmax3(t0, t1, t2), t3); \
        if constexpr (!(PRB & 64)) { auto rr = __builtin_amdgcn_permlane32_swap(__float_as_uint(pmax), __float_as_uint(pmax), false, false); pmax = vmax2(__uint_as_float(rr[0]), __uint_as_float(rr[1])); } \
        const bool keep = (PRB & 128) ? true : __all(pmax - m_reg <= THR / SCALE); const float mn = keep ? m_reg : vmax2(m_reg, pmax); \
        alpha = PEXP((m_reg - mn) * C); m_reg = mn; mnC = -mn * C; } \
    if constexpr (s_ >= 5) { constexpr int k_ = s_ - 5; \
        _Pragma("unroll") for (int e_ = 3 * k_; e_ < 3 * k_ + 3; ++e_) { if (e_ < 16) p0[e_ < 16 ? e_ : 0] = fmaf(p0[e_ < 16 ? e_ : 0], C, mnC); else if (e_ < 32) p1[(e_ >= 16 && e_ < 32) ? e_ - 16 : 0] = fmaf(p1[(e_ >= 16 && e_ < 32) ? e_ - 16 : 0], C, mnC); } \
        if constexpr (k_ >= 1 && k_ <= 8) { p0[2 * (k_ - 1)] = PEXP(p0[2 * (k_ - 1)]); p0[2 * (k_ - 1) + 1] = PEXP(p0[2 * (k_ - 1) + 1]); } } } } while (0)
#define R2_SLOT(d0, k) do { if constexpr (!(PRB & 8)) o[d0] = __builtin_amdgcn_mfma_f32_32x32x16_bf16(pa[k], PK(lo[d0][k], hh[d0][k]), o[d0], 0, 0, 0); else o[d0][k] += __builtin_bit_cast(float, (int)lo[d0][k][0] | ((int)hh[d0][k][1] << 16)) + __builtin_bit_cast(float, (int)pa[k][0]); SM_SLOT(4 * (d0) + (k)); \
    if ((d0) < 3) { if constexpr (PRB & 4) { lo[(d0) < 3 ? (d0) + 1 : 0][k] = lo[0][k]; hh[(d0) < 3 ? (d0) + 1 : 0][k] = hh[0][k]; } else { lo[(d0) < 3 ? (d0) + 1 : 0][k] = TR(v_rd_off((d0) + 1, k, 0)); hh[(d0) < 3 ? (d0) + 1 : 0][k] = TR(v_rd_off((d0) + 1, k, 1)); } } SBAR(); } while (0)
  R2_SLOT(0, 0); R2_SLOT(0, 1); R2_SLOT(0, 2); R2_SLOT(0, 3);
  R2_SLOT(1, 0); R2_SLOT(1, 1); R2_SLOT(1, 2); R2_SLOT(1, 3);
  R2_SLOT(2, 0); R2_SLOT(2, 1); R2_SLOT(2, 2); R2_SLOT(2, 3);
  R2_SLOT(3, 0); R2_SLOT(3, 1); R2_SLOT(3, 2); R2_SLOT(3, 3);
#undef R2_SLOT
#undef SM_SLOT
#undef PEXP
#undef TR
#undef PK
}

#ifndef RING4
#define RING4 1
#endif
template <int DQ> struct RingGeo { static constexpr int NSLOT = (DQ == 128 && RING4) ? 4 : 3, R_K = 0, R_KR = 49152, R_V = DQ == 192 ? 73728 : NSLOT * 16384, OFF_WS2 = R_V + NSLOT * 16384, OFF_QR2 = OFF_WS2 + 2048, BYTES = OFF_QR2 + (DQ == 192 ? NW * 4096 : 0); };
template <int DQ, bool ALIBI, bool OBF, int LDQ, int LDK, int LDV, int LDO, bool FIX>
__device__ __forceinline__ void attn_ring(const bf16_t* __restrict__ Qb, const bf16_t* __restrict__ Kh, const bf16_t* __restrict__ Vh, const bf16_t* __restrict__ KRh,
                                          void* __restrict__ Ob, int q0, int kt0, int NT, char* lds, float sig, const f32x2* csr, const f32x2* csc, unsigned* flag) {
  using RG = RingGeo<DQ>;
  constexpr int R_V = RG::R_V, R_K = RG::R_K, R_KR = RG::R_KR;
  int tid = threadIdx.x; asm volatile("" : "+v"(tid));
  const int wid = __builtin_amdgcn_readfirstlane(tid >> 6), lane = tid & 63, r32 = lane & 31, hi = lane >> 5;
  LAS char* ldsl = (LAS char*)lds;
  float* ws = (float*)(lds + RG::OFF_WS2) + wid * 64; float* li_l = ws; float* al_l = ws + 32;
  unsigned voK[2], voV[2], voKR;
#pragma unroll
  for (int i = 0; i < 2; ++i) { const int q = wid * 2 + i;
    { const int row = q * 4 + (lane >> 4), c = (lane & 15) ^ (row & 15); voK[i] = (unsigned)(row * LDK + c * 8) * 2u; }
    { const int st = q * 2 + (lane >> 5), w = lane & 31, kk = (st >> 2) * 8 + (w >> 2), c = (st & 3) * 32 + (w & 3) * 8, k = (kk & ~0xC) | ((kk & 4) << 1) | ((kk & 8) >> 1);
      voV[i] = (unsigned)(k * LDV + c) * 2u; } }
  { const int key = wid * 8 + (lane >> 3), ch = ((lane & 7) ^ (key >> 1)) & 7; voKR = (unsigned)(key * 64 + ch * 8) * 2u; }
#define DMA(buf, tile) do { const size_t k0_ = (size_t)(kt0 + (tile)) * KVBLK; const char* Vt_ = (const char*)Vh + k0_ * (LDV * 2); const char* Kt_ = (const char*)Kh + k0_ * (LDK * 2); \
    LAS char* sl_ = ldsl + (buf) + wid * 2048; \
    glds16s(voV[0], Vt_, (unsigned)(uintptr_t)(LAS char*)(sl_ + R_V)); \
    glds16s(voV[1], Vt_, (unsigned)(uintptr_t)(LAS char*)(sl_ + R_V + 1024)); \
    glds16s(voK[0], Kt_, (unsigned)(uintptr_t)(LAS char*)(sl_ + R_K)); \
    glds16s(voK[1], Kt_, (unsigned)(uintptr_t)(LAS char*)(sl_ + R_K + 1024)); \
    if constexpr (DQ == 192) glds16s(voKR, (const char*)KRh + k0_ * 128, (unsigned)(uintptr_t)(LAS char*)(ldsl + R_KR + ((buf) >> 1) + wid * 1024)); } while (0)
  DMA(0, 0); DMA(16384, 1);
  if constexpr (RG::NSLOT == 4) { if (2 < NT) DMA(32768, 2); }
  float m_reg = -1e30f, l_reg = 0; f32x16 o[4] = {}; bf16x8 qr[8];
  char* qrl = lds + RG::OFF_QR2 + wid * 4096 + lane * 16;
  const bf16_t* Qw = Qb + (long)(wid * QBLK + r32) * LDQ + hi * 8;
  constexpr float QC = FIX ? Sc<DQ>::SCALE * 1.4426950408889634f : 1.f;
#pragma unroll
  for (int d0 = 0; d0 < 8; ++d0) { qr[d0] = ld8(Qw + d0 * 16); if constexpr (FIX) qr[d0] = scale_frag(qr[d0], QC); }
  if constexpr (DQ == 192) {
    const int tok = q0 + wid * QBLK + r32;
    const f32x2* tr = csr + (tok >> 6) * 16 + hi * 8; const f32x2* tc = csc + (tok & 63) * 16 + hi * 8;
    const bf16x8 a0 = ld8(Qw + 128), a1 = ld8(Qw + 144), b0 = ld8(Qw + 160), b1 = ld8(Qw + 176);
    unsigned wa[4], wb[4], wc_[4], wd[4];
#pragma unroll
    for (int e = 0; e < 8; e += 2) {
      const f32x2 c0 = tr[e] * QC, c1 = tr[e + 1] * QC, d0_ = tc[e] * QC, d1_ = tc[e + 1] * QC;
      const float x10 = bf2f((unsigned short)a0[e]), x11 = bf2f((unsigned short)a0[e + 1]), x20 = bf2f((unsigned short)a1[e]), x21 = bf2f((unsigned short)a1[e + 1]);
      wa[e >> 1] = cvt_pk_bf16(x10 * c0.x - x20 * c0.y, x11 * c1.x - x21 * c1.y);
      wb[e >> 1] = cvt_pk_bf16(x20 * c0.x + x10 * c0.y, x21 * c1.x + x11 * c1.y);
      const float y10 = bf2f((unsigned short)b0[e]), y11 = bf2f((unsigned short)b0[e + 1]), y20 = bf2f((unsigned short)b1[e]), y21 = bf2f((unsigned short)b1[e + 1]);
      wc_[e >> 1] = cvt_pk_bf16(y10 * d0_.x - y20 * d0_.y, y11 * d1_.x - y21 * d1_.y);
      wd[e >> 1] = cvt_pk_bf16(y20 * d0_.x + y10 * d0_.y, y21 * d1_.x + y11 * d1_.y);
    }
    *(u32x4*)(qrl) = (u32x4){wa[0], wa[1], wa[2], wa[3]};
    *(u32x4*)(qrl + 1024) = (u32x4){wb[0], wb[1], wb[2], wb[3]};
    *(u32x4*)(qrl + 2048) = (u32x4){wc_[0], wc_[1], wc_[2], wc_[3]};
    *(u32x4*)(qrl + 3072) = (u32x4){wd[0], wd[1], wd[2], wd[3]};
  }
  int ka[12];
#pragma unroll
  for (int i = 0; i < 8; ++i) { ka[i] = (int)(uintptr_t)ldsl + KSWZ(r32, (i * 16 + hi * 8) * 2); asm volatile("" : "+v"(ka[i])); }
#pragma unroll
  for (int i = 8; i < 12; ++i) { ka[i] = 0; if constexpr (DQ == 192) { ka[i] = (int)(uintptr_t)ldsl + 32768 + KRO(r32, 2 * (i - 8) + hi); asm volatile("" : "+v"(ka[i])); } }
  int vb0 = (int)(uintptr_t)ldsl + R_V + v_rd_base(lane); asm volatile("" : "+v"(vb0));
  const int qw0 = q0 + wid * QBLK;
  const float dq0 = (float)(qw0 + r32 - 4 * hi);
#define RESC(a) do { if (__any((a) < 1.f)) { if (hi == 0) al_l[r32] = (a); asm volatile("s_waitcnt lgkmcnt(0)" ::: "memory"); \
    _Pragma("unroll") for (int d = 0; d < 4; ++d) _Pragma("unroll") for (int r = 0; r < 16; ++r) o[d][r] *= al_l[crow(r, hi)]; } } while (0)
#define PINIT(P0, P1, tj) do { if constexpr (ALIBI) { const int k0_ = (kt0 + (tj)) * KVBLK; alibi_init(P0, P1, dq0 - (float)k0_, sig, qw0 - k0_); } else { P0 = f32x16{}; P1 = f32x16{}; } } while (0)
#define STEP(PC0, PC1, MNC, ALC, PP0, PP1, ALP, tj) do { \
    if constexpr (NSLOT == 4) { if ((tj) + 1 < NT) asm volatile("s_waitcnt vmcnt(4)" ::: "memory"); else asm volatile("s_waitcnt vmcnt(0)" ::: "memory"); } \
    else asm volatile("s_waitcnt vmcnt(0)" ::: "memory"); \
    __builtin_amdgcn_s_barrier(); \
    if constexpr (NSLOT == 4) { if ((tj) + 2 < NT) DMA(on2, (tj) + 2); } else { if ((tj) + 1 < NT) DMA(on, (tj) + 1); } \
    PINIT(PC0, PC1, tj); SBAR(); \
    region1<DQ, PRBV, FIX, 0>(PC0, PC1, R_K + oc, R_KR + (oc >> 1) - 32768, qr, (const LAS char*)qrl, ka, r32, hi, PP0, PP1, ALP, l_reg, pa0, pa1, pa2, pa3); SBAR(); \
    region2<DQ, PRBV, FIX>(o, vb0 + op, pa0, pa1, pa2, pa3, PC0, PC1, m_reg, ALC); SBAR(); \
    if constexpr (!FIX) RESC(ALC); { const int t_ = op; op = oc; oc = on; if constexpr (NSLOT == 4) { on = on2; on2 = t_; } else on = t_; } } while (0)
  constexpr int NSLOT = RG::NSLOT;
  constexpr int PRBV = (!ALIBI && DQ == 128) ? PROBE_GQA : 0;
  if (wid >= 4) __builtin_amdgcn_s_setprio(1);
  f32x16 pA0, pA1, pB0, pB1; float mnA, mnB, alA, alB; bf16x8 pa0, pa1, pa2, pa3;
  int op = 0, oc = 16384, on = 32768, on2 = 49152;
  asm volatile("s_waitcnt vmcnt(0)" ::: "memory");
  __builtin_amdgcn_s_barrier();
  PINIT(pA0, pA1, 0); qkt_pipe<DQ, 0>(pA0, pA1, ldsl + R_K, ldsl + R_KR, qr, (const LAS char*)qrl, r32, hi); if constexpr (FIX) { _Pragma("unroll") for (int r = 0; r < 16; ++r) { pA0[r] = __builtin_amdgcn_exp2f(pA0[r]); pA1[r] = __builtin_amdgcn_exp2f(pA1[r]); } alA = 1.f; } else partialSM_nb<DQ>(pA0, pA1, m_reg, alA);
  if constexpr (NSLOT == 4) {
#define STEP4(PC0, PC1, ALC, PP0, PP1, ALP, SC, SP, SN2, tj) do { \
    if ((tj) + 1 < NT) asm volatile("s_waitcnt vmcnt(4)" ::: "memory"); else asm volatile("s_waitcnt vmcnt(0)" ::: "memory"); \
    __builtin_amdgcn_s_barrier(); \
    if ((tj) + 2 < NT) DMA((SN2) * 16384, (tj) + 2); \
    PINIT(PC0, PC1, tj); SBAR(); \
    region1<DQ, PRBV, FIX, R_K + (SC) * 16384, R_KR>(PC0, PC1, 0, 0, qr, (const LAS char*)qrl, ka, r32, hi, PP0, PP1, ALP, l_reg, pa0, pa1, pa2, pa3); SBAR(); \
    { int vb_ = vb0; asm volatile("" : "+v"(vb_)); region2<DQ, PRBV, FIX>(o, vb_ + (SP) * 16384, pa0, pa1, pa2, pa3, PC0, PC1, m_reg, ALC); } SBAR(); \
    if constexpr (!FIX) RESC(ALC); } while (0)
    STEP4(pB0, pB1, alB, pA0, pA1, alA, 1, 0, 3, 1);
    STEP4(pA0, pA1, alA, pB0, pB1, alB, 2, 1, 0, 2);
    STEP4(pB0, pB1, alB, pA0, pA1, alA, 3, 2, 1, 3);
    for (int j = 4; j < NT; j += 4) {
      STEP4(pA0, pA1, alA, pB0, pB1, alB, 0, 3, 2, j);
      STEP4(pB0, pB1, alB, pA0, pA1, alA, 1, 0, 3, j + 1);
      STEP4(pA0, pA1, alA, pB0, pB1, alB, 2, 1, 0, j + 2);
      STEP4(pB0, pB1, alB, pA0, pA1, alA, 3, 2, 1, j + 3);
    }
#undef STEP4
    if constexpr (FIX) finishSM_noexp(pB0, pB1, l_reg, pa0, pa1, pa2, pa3); else finishSM_nb(pB0, pB1, alB, l_reg, pa0, pa1, pa2, pa3); SBAR();
    pv_pipe<0>(o, vb0 + 3 * 16384, pa0, pa1, pa2, pa3);
  } else if (NT % 6 == 4) {
#define STEP3(PC0, PC1, ALC, PP0, PP1, ALP, SC, SP, SN, tj) do { \
    asm volatile("s_waitcnt vmcnt(0)" ::: "memory"); __builtin_amdgcn_s_barrier(); \
    if ((tj) + 1 < NT) DMA((SN) * 16384, (tj) + 1); \
    PINIT(PC0, PC1, tj); SBAR(); \
    region1<DQ, PRBV, FIX, R_K + (SC) * 16384, R_KR + (SC) * 8192 - 32768>(PC0, PC1, 0, 0, qr, (const LAS char*)qrl, ka, r32, hi, PP0, PP1, ALP, l_reg, pa0, pa1, pa2, pa3); SBAR(); \
    { int vb_ = vb0; asm volatile("" : "+v"(vb_)); region2<DQ, PRBV, FIX>(o, vb_ + (SP) * 16384, pa0, pa1, pa2, pa3, PC0, PC1, m_reg, ALC); } SBAR(); \
    if constexpr (!FIX) RESC(ALC); } while (0)
    STEP3(pB0, pB1, alB, pA0, pA1, alA, 1, 0, 2, 1);
    STEP3(pA0, pA1, alA, pB0, pB1, alB, 2, 1, 0, 2);
    STEP3(pB0, pB1, alB, pA0, pA1, alA, 0, 2, 1, 3);
    for (int j = 4; j < NT; j += 6) {
      STEP3(pA0, pA1, alA, pB0, pB1, alB, 1, 0, 2, j);
      STEP3(pB0, pB1, alB, pA0, pA1, alA, 2, 1, 0, j + 1);
      STEP3(pA0, pA1, alA, pB0, pB1, alB, 0, 2, 1, j + 2);
      STEP3(pB0, pB1, alB, pA0, pA1, alA, 1, 0, 2, j + 3);
      STEP3(pA0, pA1, alA, pB0, pB1, alB, 2, 1, 0, j + 4);
      STEP3(pB0, pB1, alB, pA0, pA1, alA, 0, 2, 1, j + 5);
    }
#undef STEP3
    if constexpr (FIX) finishSM_noexp(pB0, pB1, l_reg, pa0, pa1, pa2, pa3); else finishSM_nb(pB0, pB1, alB, l_reg, pa0, pa1, pa2, pa3); SBAR();
    pv_pipe<0>(o, vb0, pa0, pa1, pa2, pa3);
  } else {
    for (int j = 1; j + 1 < NT; j += 2) {
      STEP(pB0, pB1, mnB, alB, pA0, pA1, alA, j);
      STEP(pA0, pA1, mnA, alA, pB0, pB1, alB, j + 1);
    }
    STEP(pB0, pB1, mnB, alB, pA0, pA1, alA, NT - 1);
    if constexpr (FIX) finishSM_noexp(pB0, pB1, l_reg, pa0, pa1, pa2, pa3); else finishSM_nb(pB0, pB1, alB, l_reg, pa0, pa1, pa2, pa3); SBAR();
    pv_pipe<0>(o, vb0 + op, pa0, pa1, pa2, pa3);
  }
  __builtin_amdgcn_s_setprio(0);
  if constexpr (FIX) { if (__any(!(l_reg > 1e-30f && l_reg < 1e30f)) && lane == 0) atomicOr(flag, 1u); }
  if (hi == 0) li_l[r32] = l_reg; asm volatile("s_waitcnt lgkmcnt(0)" ::: "memory");
  int lane_e = lane; asm volatile("" : "+v"(lane_e));
  const int r32e = lane_e & 31, hie = lane_e >> 5;
  float rli[16];
#pragma unroll
  for (int r = 0; r < 16; ++r) rli[r] = __builtin_amdgcn_rcpf(li_l[crow(r, hie)]);
  if constexpr (OBF) {
    bf16_t* Ow = (bf16_t*)Ob + (size_t)(wid * QBLK) * LDO + (unsigned)(4 * hie * LDO + r32e);
#pragma unroll
    for (int r = 0; r < 16; ++r) { const int orow = (r & 3) + 8 * (r >> 2);
#pragma unroll
      for (int d0 = 0; d0 < 4; ++d0) { float val = o[d0][r] * rli[r]; if constexpr (PRBV != 0) val = (val == val && fabsf(val) < 1e20f) ? val * 1e-20f : 0.f; Ow[orow * LDO + d0 * 32] = (bf16_t)f2bf(val); } }
  } else {
    float* Ow = (float*)Ob + (size_t)(wid * QBLK) * LDO + (unsigned)(4 * hie * LDO + r32e);
#pragma unroll
    for (int r = 0; r < 16; ++r) { const int orow = (r & 3) + 8 * (r >> 2);
#pragma unroll
      for (int d0 = 0; d0 < 4; ++d0) Ow[orow * LDO + d0 * 32] = o[d0][r] * rli[r]; }
  }
#undef DMA
#undef RESC
#undef PINIT
#undef STEP
}
#ifndef PROBE_PP
#define PROBE_PP 0
#endif
template <int KOFF, bool DO_QK, bool DO_PV, int PRB>
__device__ __forceinline__ void pp_mseg(f32x16& p0, f32x16& p1, const LAS char* kp, const int* ka, const bf16x8* qr, f32x16* o, int vb, bf16x8 pa0, bf16x8 pa1, bf16x8 pa2, bf16x8 pa3) {
#define TR(off) __builtin_amdgcn_ds_read_tr16_b64_v4i16((LAS s16x4*)(uintptr_t)(unsigned)(vb + (off)))
#define PK(L, H) (bf16x8){L[0], L[1], L[2], L[3], H[0], H[1], H[2], H[3]}
  bf16x8 fa[8], fb[8]; s16x4 lo[4][4], hh[4][4];
  int kl[8];
#pragma unroll
  for (int i = 0; i < 8; ++i) { kl[i] = ka[i]; asm volatile("" : "+v"(kl[i])); }
#define RDK(i) do { fa[i] = *(const LAS bf16x8*)((kp + kl[i]) + KOFF); fb[i] = *(const LAS bf16x8*)((kp + kl[i]) + (KOFF + 8192)); } while (0)
#define RDV(d0, k) do { lo[d0][k] = TR(v_rd_off(d0, k, 0)); hh[d0][k] = TR(v_rd_off(d0, k, 1)); } while (0)
  if constexpr (DO_QK) {
    RDK(0); RDK(1); SBAR();
#define QK_PAIR(i) do { if constexpr (!(PRB & 2)) p0 = __builtin_amdgcn_mfma_f32_32x32x16_bf16(fa[i], qr[i], p0, 0, 0, 0); else p0[i] += __builtin_bit_cast(float, (int)fa[i][0]); \
      if constexpr ((i) + 2 < 8) RDK((i) + 2 < 8 ? (i) + 2 : 0); else if constexpr (DO_PV) { RDV(0, ((i) - 6) * 2); RDV(0, ((i) - 6) * 2 + 1); } SBAR(); \
      if constexpr (!(PRB & 2)) p1 = __builtin_amdgcn_mfma_f32_32x32x16_bf16(fb[i], qr[i], p1, 0, 0, 0); else p1[i] += __builtin_bit_cast(float, (int)fb[i][0]); SBAR(); } while (0)
    QK_PAIR(0); QK_PAIR(1); QK_PAIR(2); QK_PAIR(3); QK_PAIR(4); QK_PAIR(5); QK_PAIR(6); QK_PAIR(7);
#undef QK_PAIR
  } else if constexpr (DO_PV) { RDV(0, 0); RDV(0, 1); RDV(0, 2); RDV(0, 3); SBAR(); }
  if constexpr (DO_PV) {
    const bf16x8 pa[4] = {pa0, pa1, pa2, pa3};
#define PV_SLOT(d0, k) do { if constexpr (!(PRB & 2)) o[d0] = __builtin_amdgcn_mfma_f32_32x32x16_bf16(pa[k], PK(lo[d0][k], hh[d0][k]), o[d0], 0, 0, 0); else o[d0][k] += __builtin_bit_cast(float, (int)lo[d0][k][0] | ((int)hh[d0][k][1] << 16)); if constexpr ((d0) < 3) RDV((d0) < 3 ? (d0) + 1 : 0, k); SBAR(); } while (0)
    PV_SLOT(0, 0); PV_SLOT(0, 1); PV_SLOT(0, 2); PV_SLOT(0, 3); PV_SLOT(1, 0); PV_SLOT(1, 1); PV_SLOT(1, 2); PV_SLOT(1, 3);
    PV_SLOT(2, 0); PV_SLOT(2, 1); PV_SLOT(2, 2); PV_SLOT(2, 3); PV_SLOT(3, 0); PV_SLOT(3, 1); PV_SLOT(3, 2); PV_SLOT(3, 3);
#undef PV_SLOT
  }
#undef RDK
#undef RDV
#undef TR
#undef PK
}
template <int DQ>
__device__ __forceinline__ void pp_softmax(const f32x16& p0, const f32x16& p1, float& m_reg, float& l_reg, float& alpha, bf16x8& pa0, bf16x8& pa1, bf16x8& pa2, bf16x8& pa3) {
  constexpr float SCALE = Sc<DQ>::SCALE, C = SCALE * 1.4426950408889634f;
  float t0 = vmax2(vmax3(vmax3(vmax3(p0[0], p0[1], p0[2]), p0[3], p0[4]), p0[5], p0[6]), p0[7]);
  float t1 = vmax2(vmax3(vmax3(vmax3(p0[8], p0[9], p0[10]), p0[11], p0[12]), p0[13], p0[14]), p0[15]);
  float t2 = vmax2(vmax3(vmax3(vmax3(p1[0], p1[1], p1[2]), p1[3], p1[4]), p1[5], p1[6]), p1[7]);
  float t3 = vmax2(vmax3(vmax3(vmax3(p1[8], p1[9], p1[10]), p1[11], p1[12]), p1[13], p1[14]), p1[15]);
  float pmax = vmax2(vmax3(t0, t1, t2), t3);
  { auto rr = __builtin_amdgcn_permlane32_swap(__float_as_uint(pmax), __float_as_uint(pmax), false, false); pmax = vmax2(__uint_as_float(rr[0]), __uint_as_float(rr[1])); }
  const bool keep = __all(pmax - m_reg <= THR / SCALE);
  const float mn = keep ? m_reg : vmax2(m_reg, pmax);
  alpha = __builtin_amdgcn_exp2f((m_reg - mn) * C); m_reg = mn;
  const float mnC = -mn * C;
  float e0[16], e1[16];
#pragma unroll
  for (int r = 0; r < 16; ++r) { e0[r] = __builtin_amdgcn_exp2f(fmaf(p0[r], C, mnC)); e1[r] = __builtin_amdgcn_exp2f(fmaf(p1[r], C, mnC)); }
  float s0 = 0.f, s1 = 0.f, s2 = 0.f, s3 = 0.f;
#pragma unroll
  for (int r = 0; r < 16; r += 2) { s0 += e0[r]; s1 += e0[r + 1]; s2 += e1[r]; s3 += e1[r + 1]; }
  float ps = (s0 + s1) + (s2 + s3);
  { auto rr = __builtin_amdgcn_permlane32_swap(__float_as_uint(ps), __float_as_uint(ps), false, false); ps = __uint_as_float(rr[0]) + __uint_as_float(rr[1]); }
  l_reg = l_reg * alpha + ps;
#define PK4(E, BASE, OUT) do { unsigned a0 = cvt2(E[BASE + 0], E[BASE + 1]), a1 = cvt2(E[BASE + 2], E[BASE + 3]), b0 = cvt2(E[BASE + 4], E[BASE + 5]), b1 = cvt2(E[BASE + 6], E[BASE + 7]); \
    u32x4 w = {a0, a1, b0, b1}; OUT = *reinterpret_cast<bf16x8*>(&w); } while (0)
  PK4(e0, 0, pa0); PK4(e0, 8, pa1); PK4(e1, 0, pa2); PK4(e1, 8, pa3);
#undef PK4
}
__device__ __forceinline__ void pp_softmax_fix(const f32x16& p0, const f32x16& p1, float& l_reg, bf16x8& pa0, bf16x8& pa1, bf16x8& pa2, bf16x8& pa3) {
  float e0[16], e1[16];
#pragma unroll
  for (int r = 0; r < 16; ++r) { e0[r] = __builtin_amdgcn_exp2f(p0[r]); e1[r] = __builtin_amdgcn_exp2f(p1[r]); }
  float s0 = 0.f, s1 = 0.f, s2 = 0.f, s3 = 0.f;
#pragma unroll
  for (int r = 0; r < 16; r += 2) { s0 += e0[r]; s1 += e0[r + 1]; s2 += e1[r]; s3 += e1[r + 1]; }
  float ps = (s0 + s1) + (s2 + s3);
  { auto rr = __builtin_amdgcn_permlane32_swap(__float_as_uint(ps), __float_as_uint(ps), false, false); ps = __uint_as_float(rr[0]) + __uint_as_float(rr[1]); }
  l_reg += ps;
#define PK4(E, BASE, OUT) do { unsigned a0 = cvt2(E[BASE + 0], E[BASE + 1]), a1 = cvt2(E[BASE + 2], E[BASE + 3]), b0 = cvt2(E[BASE + 4], E[BASE + 5]), b1 = cvt2(E[BASE + 6], E[BASE + 7]); \
    u32x4 w = {a0, a1, b0, b1}; OUT = *reinterpret_cast<bf16x8*>(&w); } while (0)
  PK4(e0, 0, pa0); PK4(e0, 8, pa1); PK4(e1, 0, pa2); PK4(e1, 8, pa3);
#undef PK4
}
template <int DQ, bool ALIBI, bool OBF, int LDQ, int LDK, int LDV, int LDO, bool FIX>
__device__ __forceinline__ void attn_pp(const bf16_t* __restrict__ Qb, const bf16_t* __restrict__ Kh, const bf16_t* __restrict__ Vh,
                                        void* __restrict__ Ob, int q0, int kt0, int NT, char* lds, float sig, unsigned* flag) {
  static_assert(DQ == 128, "ping-pong body: head dim 128");
  constexpr int PRBP = ALIBI ? 0 : PROBE_PP;
  constexpr int R_K = 0, R_V = 65536, OFF_WS2 = 131072;
  int tid = threadIdx.x; asm volatile("" : "+v"(tid));
  const int wid = __builtin_amdgcn_readfirstlane(tid >> 6), lane = tid & 63, r32 = lane & 31, hi = lane >> 5;
  const bool late = wid >= 4;
  LAS char* ldsl = (LAS char*)lds;
  float* ws = (float*)(lds + OFF_WS2) + wid * 64; float* li_l = ws; float* al_l = ws + 32;
  float m_reg = -1e30f, l_reg = 0.f, alpha = 1.f; f32x16 o[4] = {}; bf16x8 qr[8];
  const bf16_t* Qw = Qb + (long)(wid * QBLK + r32) * LDQ + hi * 8;
  constexpr float QC = FIX ? Sc<DQ>::SCALE * 1.4426950408889634f : 1.f;
#pragma unroll
  for (int d0 = 0; d0 < 8; ++d0) { qr[d0] = ld8(Qw + d0 * 16); if constexpr (FIX) qr[d0] = scale_frag(qr[d0], QC); }
  unsigned voK[2], voV[2];
#pragma unroll
  for (int i = 0; i < 2; ++i) { const int q = wid * 2 + i;
    { const int row = q * 4 + (lane >> 4), c = (lane & 15) ^ (row & 15); voK[i] = (unsigned)(row * LDK + c * 8) * 2u; }
    { const int st = q * 2 + (lane >> 5), w = lane & 31, kk = (st >> 2) * 8 + (w >> 2), c = (st & 3) * 32 + (w & 3) * 8, k = (kk & ~0xC) | ((kk & 4) << 1) | ((kk & 8) >> 1);
      voV[i] = (unsigned)(k * LDV + c) * 2u; } }
  int ka[8];
#pragma unroll
  for (int i = 0; i < 8; ++i) { ka[i] = KSWZ(r32, (i * 16 + hi * 8) * 2); asm volatile("" : "+v"(ka[i])); }
  int vb0 = (int)(uintptr_t)ldsl + R_V + v_rd_base(lane); asm volatile("" : "+v"(vb0));
  const int qw0 = q0 + wid * QBLK;
  const float dq0 = (float)(qw0 + r32 - 4 * hi);
#define DMA(slot, tile) do { const size_t k0_ = (size_t)(kt0 + (tile)) * KVBLK; const char* Vt_ = (const char*)Vh + k0_ * (LDV * 2); const char* Kt_ = (const char*)Kh + k0_ * (LDK * 2); \
    LAS char* sl_ = ldsl + (slot) * 16384 + wid * 2048; \
    glds16s(voV[0], Vt_, (unsigned)(uintptr_t)(LAS char*)(sl_ + R_V)); \
    glds16s(voV[1], Vt_, (unsigned)(uintptr_t)(LAS char*)(sl_ + R_V + 1024)); \
    glds16s(voK[0], Kt_, (unsigned)(uintptr_t)(LAS char*)(sl_ + R_K)); \
    glds16s(voK[1], Kt_, (unsigned)(uintptr_t)(LAS char*)(sl_ + R_K + 1024)); } while (0)
#define RESC(a) do { if (__any((a) < 1.f)) { if (hi == 0) al_l[r32] = (a); asm volatile("s_waitcnt lgkmcnt(0)" ::: "memory"); \
    _Pragma("unroll") for (int d = 0; d < 4; ++d) _Pragma("unroll") for (int r = 0; r < 16; ++r) o[d][r] *= al_l[crow(r, hi)]; } } while (0)
#define PINIT(tj) do { if constexpr (ALIBI) { const int k0_ = (kt0 + (tj)) * KVBLK; alibi_init(pc0, pc1, dq0 - (float)k0_, sig, qw0 - k0_); } else { pc0 = f32x16{}; pc1 = f32x16{}; } } while (0)
#define BAR() __builtin_amdgcn_s_barrier()
  f32x16 pc0, pc1; bf16x8 pa0, pa1, pa2, pa3;
#define PP_STEP(SC, SP, SN2, tj, FIRST) do { \
    BAR(); if ((tj) + 2 < NT) DMA(SN2, (tj) + 2); SBAR(); \
    { int vb_ = vb0; asm volatile("" : "+v"(vb_)); pp_mseg<R_K + (SC) * 16384, true, !(FIRST), PRBP>(pc0, pc1, ldsl, ka, qr, o, vb_ + (SP) * 16384, pa0, pa1, pa2, pa3); } SBAR(); \
    if ((tj) + 2 < NT) asm volatile("s_waitcnt vmcnt(4)" ::: "memory"); else asm volatile("s_waitcnt vmcnt(0)" ::: "memory"); \
    BAR(); \
    if constexpr (FIX) { pp_softmax_fix(pc0, pc1, l_reg, pa0, pa1, pa2, pa3); } else if constexpr (!(PRBP & 1)) { pp_softmax<DQ>(pc0, pc1, m_reg, l_reg, alpha, pa0, pa1, pa2, pa3); RESC(alpha); } else { pa0 = qr[0]; pa1 = qr[1]; pa2 = qr[2]; pa3 = qr[3]; l_reg += pc0[0]; } \
    if ((tj) + 1 < NT) PINIT((tj) + 1); SBAR(); } while (0)
  DMA(0, 0); DMA(1, 1);
  asm volatile("s_waitcnt vmcnt(4)" ::: "memory");
  PINIT(0);
  if (late) BAR();
  PP_STEP(0, 3, 2, 0, true);
  PP_STEP(1, 0, 3, 1, false);
  PP_STEP(2, 1, 0, 2, false);
  PP_STEP(3, 2, 1, 3, false);
  for (int j = 4; j < NT; j += 4) {
    PP_STEP(0, 3, 2, j, false);
    PP_STEP(1, 0, 3, j + 1, false);
    PP_STEP(2, 1, 0, j + 2, false);
    PP_STEP(3, 2, 1, j + 3, false);
  }
  BAR();
  { int vb_ = vb0; asm volatile("" : "+v"(vb_)); pp_mseg<0, false, true, PRBP>(pc0, pc1, ldsl, ka, qr, o, vb_ + 3 * 16384, pa0, pa1, pa2, pa3); }
  if (!late) BAR();
  if constexpr (FIX) { if (__any(!(l_reg > 1e-30f && l_reg < 1e30f)) && lane == 0) atomicOr(flag, 1u); }
  if (hi == 0) li_l[r32] = l_reg; asm volatile("s_waitcnt lgkmcnt(0)" ::: "memory");
  int lane_e = lane; asm volatile("" : "+v"(lane_e));
  const int r32e = lane_e & 31, hie = lane_e >> 5;
  float rli[16];
#pragma unroll
  for (int r = 0; r < 16; ++r) rli[r] = __builtin_amdgcn_rcpf(li_l[crow(r, hie)]);
  if constexpr (OBF) {
    bf16_t* Ow = (bf16_t*)Ob + (size_t)(wid * QBLK) * LDO + (unsigned)(4 * hie * LDO + r32e);
#pragma unroll
    for (int r = 0; r < 16; ++r) { const int orow = (r & 3) + 8 * (r >> 2);
#pragma unroll
      for (int d0 = 0; d0 < 4; ++d0) { float val = o[d0][r] * rli[r]; if constexpr (PRBP != 0) val = (val == val && fabsf(val) < 1e20f) ? val * 1e-20f : 0.f; Ow[orow * LDO + d0 * 32] = (bf16_t)f2bf(val); } }
  } else {
    float* Ow = (float*)Ob + (size_t)(wid * QBLK) * LDO + (unsigned)(4 * hie * LDO + r32e);
#pragma unroll
    for (int r = 0; r < 16; ++r) { const int orow = (r & 3) + 8 * (r >> 2);
#pragma unroll
      for (int d0 = 0; d0 < 4; ++d0) Ow[orow * LDO + d0 * 32] = o[d0][r] * rli[r]; }
  }
#undef DMA
#undef RESC
#undef PINIT
#undef BAR
#undef PP_STEP
}
}

constexpr int N_IN = 24;
enum { I_X = 0, I_AB_WIN, I_AB_QN, I_AB_KN, I_LQ1, I_LK1, I_LQ2, I_LK2, I_SUBLN, I_AB_WOUT, I_M_WIN, I_M_QN, I_M_KVN, I_M_WUQ, I_M_WUKV, I_M_WOUT,
       I_LNM_G, I_LNM_B, I_ROUTER, I_WGATE, I_WUP, I_WDOWN, I_LNF_G, I_LNF_B };
struct Args { const float* in[N_IN]; float* out; unsigned char* ws; int ph_lo, ph_hi; };
struct Frame { LAS unsigned char* lds; char* ldsg; int tid, lane, wave, G, gw, NGW; };

__device__ __forceinline__ void transpose_item(const float* W, int K, int N, bf16_t* WT, int k0, int n0, int drow0, LAS float* scr, int lane) {
#pragma unroll 8
    for (int i = 0; i < 32; ++i) { const int kk = 2 * i + (lane >> 5); scr[kk * 33 + (lane & 31)] = W[(size_t)(k0 + kk) * N + n0 + (lane & 31)]; }
    LDS_WAIT(); asm volatile("" ::: "memory");
    const int c = lane & 7;
#pragma unroll
    for (int j = 0; j < 4; ++j) { const int n = (lane >> 3) + 8 * j; const LAS float* s = scr + (8 * c) * 33 + n;
        u32x4 o; o.x = pk2(s[0 * 33], s[1 * 33]); o.y = pk2(s[2 * 33], s[3 * 33]); o.z = pk2(s[4 * 33], s[5 * 33]); o.w = pk2(s[6 * 33], s[7 * 33]);
        *(u32x4*)(WT + (size_t)(drow0 + n) * K + k0 + 8 * c) = o; }
    LDS_WAIT(); asm volatile("" ::: "memory");
}
template <int MODE>
__device__ __forceinline__ void transpose_matrix(const Frame& F, const float* W, int K, int N, bf16_t* WT, LAS float* scr) {
    const int nblk = N / 32, nitems = (K / 64) * nblk;
    for (int it = F.gw; it < nitems; it += F.NGW) {
        const int kb = it / nblk, nb = it % nblk, n0 = 32 * nb;
        int drow0 = n0;
        if (MODE == 1) drow0 = (n0 >> 7) * 256 + (n0 & 127);
        if (MODE == 2) drow0 = (n0 >> 7) * 256 + 128 + (n0 & 127);
        transpose_item(W, K, N, WT, 64 * kb, n0, drow0, scr, F.lane);
    }
}
__device__ __forceinline__ void transpose_item_f8(const float* W, int K, int N, unsigned char* WT, int k0, int n0, int drow0, float sc, LAS float* scr, int lane) {
#pragma unroll 8
    for (int i = 0; i < 32; ++i) { const int kk = 2 * i + (lane >> 5); scr[kk * 33 + (lane & 31)] = __builtin_nontemporal_load(&W[(size_t)(k0 + kk) * N + n0 + (lane & 31)]); }
    LDS_WAIT(); asm volatile("" ::: "memory");
    const int c = lane & 3;
#pragma unroll
    for (int j = 0; j < 2; ++j) { const int n = (lane >> 2) + 16 * j; const LAS float* s = scr + (16 * c) * 33 + n;
        u32x4 o; o.x = pk4_fp8(s[0 * 33] * sc, s[1 * 33] * sc, s[2 * 33] * sc, s[3 * 33] * sc); o.y = pk4_fp8(s[4 * 33] * sc, s[5 * 33] * sc, s[6 * 33] * sc, s[7 * 33] * sc);
        o.z = pk4_fp8(s[8 * 33] * sc, s[9 * 33] * sc, s[10 * 33] * sc, s[11 * 33] * sc); o.w = pk4_fp8(s[12 * 33] * sc, s[13 * 33] * sc, s[14 * 33] * sc, s[15 * 33] * sc);
        *(u32x4*)(WT + (size_t)(drow0 + n) * K + k0 + 16 * c) = o; }
    LDS_WAIT(); asm volatile("" ::: "memory");
}
__device__ __forceinline__ void transpose_pair_f8(const float* W, int K, int N, unsigned char* WT, int k0, int n0, int drow0, float sc, LAS float* scr, int lane) {
    const int r8 = lane >> 3, c4 = (lane & 7) * 4;
    const float* src = W + (size_t)(k0 + r8) * N + n0 + c4;
    f32x4 va[8], vb[8];
#pragma unroll
    for (int i = 0; i < 8; ++i) va[i] = __builtin_nontemporal_load((const f32x4*)(src + (size_t)(8 * i) * N));
#pragma unroll
    for (int i = 0; i < 8; ++i) vb[i] = __builtin_nontemporal_load((const f32x4*)(src + (size_t)(64 + 8 * i) * N));
#pragma unroll
    for (int h = 0; h < 2; ++h) {
#pragma unroll
        for (int i = 0; i < 8; ++i) { const f32x4 v = h ? vb[i] : va[i]; LAS float* d = scr + (8 * i + r8) * 33 + c4; d[0] = v.x; d[1] = v.y; d[2] = v.z; d[3] = v.w; }
        LDS_WAIT(); asm volatile("" ::: "memory");
        const int c = lane & 3;
#pragma unroll
        for (int j = 0; j < 2; ++j) { const int n = (lane >> 2) + 16 * j; const LAS float* p = scr + (16 * c) * 33 + n;
            u32x4 o; o.x = pk4_fp8(p[0 * 33] * sc, p[1 * 33] * sc, p[2 * 33] * sc, p[3 * 33] * sc); o.y = pk4_fp8(p[4 * 33] * sc, p[5 * 33] * sc, p[6 * 33] * sc, p[7 * 33] * sc);
            o.z = pk4_fp8(p[8 * 33] * sc, p[9 * 33] * sc, p[10 * 33] * sc, p[11 * 33] * sc); o.w = pk4_fp8(p[12 * 33] * sc, p[13 * 33] * sc, p[14 * 33] * sc, p[15 * 33] * sc);
            *(u32x4*)(WT + (size_t)(drow0 + n) * K + k0 + 64 * h + 16 * c) = o; }
        LDS_WAIT(); asm volatile("" ::: "memory");
    }
}
template <int MODE>
__device__ __forceinline__ void transpose_matrix_pairs_f8(const float* W, int K, int N, unsigned char* WT, float sc, LAS float* scr, int gw, int ngw, int lane) {
    const int nblk = N / 32, nitems = (K / 128) * nblk;
    for (int it = gw; it < nitems; it += ngw) {
        const int kb = it / nblk, nb = it % nblk, n0 = 32 * nb;
        int drow0 = n0;
        if (MODE == 1) drow0 = (n0 >> 7) * 256 + (n0 & 127);
        if (MODE == 2) drow0 = (n0 >> 7) * 256 + 128 + (n0 & 127);
        transpose_pair_f8(W, K, N, WT, 128 * kb, n0, drow0, sc, scr, lane);
    }
}
template <int MODE>
__device__ __forceinline__ void transpose_matrix_f8(const Frame& F, const float* W, int K, int N, unsigned char* WT, float sc, LAS float* scr) {
    const int nblk = N / 32, nitems = (K / 64) * nblk;
    for (int it = F.gw; it < nitems; it += F.NGW) {
        const int kb = it / nblk, nb = it % nblk, n0 = 32 * nb;
        int drow0 = n0;
        if (MODE == 1) drow0 = (n0 >> 7) * 256 + (n0 & 127);
        if (MODE == 2) drow0 = (n0 >> 7) * 256 + 128 + (n0 & 127);
        transpose_item_f8(W, K, N, WT, 64 * kb, n0, drow0, sc, scr, F.lane);
    }
}
__device__ __forceinline__ void sincos_d(double a, double& s, double& c) {
    const double k = rint(a * 0.15915494309189535);
    double r = fma(-k, 6.283185307179586, a); r = fma(-k, 2.4492935982947064e-16, r);
    const double x = r * 0.125, x2 = x * x;
    double sp = x * (1.0 + x2 * (-1.0 / 6 + x2 * (1.0 / 120 + x2 * (-1.0 / 5040 + x2 * (1.0 / 362880 + x2 * (-1.0 / 39916800 + x2 * (1.0 / 6227020800.0)))))));
    double cp = 1.0 + x2 * (-0.5 + x2 * (1.0 / 24 + x2 * (-1.0 / 720 + x2 * (1.0 / 40320 + x2 * (-1.0 / 3628800 + x2 * (1.0 / 479001600.0 + x2 * (-1.0 / 87178291200.0)))))));
#pragma unroll
    for (int i = 0; i < 3; ++i) { const double s2 = 2.0 * sp * cp, c2 = cp * cp - sp * sp; sp = s2; cp = c2; }
    s = sp; c = cp;
}
__device__ __forceinline__ void phase_prologue(const Frame& F, const Args& a) {
    LAS float* scr = (LAS float*)(F.lds + RING_OFF + F.wave * 16384);
    unsigned char* ws = a.ws;
    for (int id = blockIdx.x * NTHR + F.tid; id < TAB_N; id += F.G * NTHR) {
        int pos, i, nf;
        if (id < TAB_C128) { pos = id / 32; i = id % 32; nf = 32; }
        else if (id < TAB_R64) { pos = (id - TAB_C128) / 32; i = id % 32; nf = 32; }
        else if (id < TAB_C64) { pos = (id - TAB_R64) / 16; i = id % 16; nf = 16; }
        else { pos = (id - TAB_C64) / 16; i = id % 16; nf = 16; }
        const int steps = nf == 32 ? i : 2 * i;
        double f = 1.0; for (int j = 0; j < steps; ++j) f *= 0.7498942093324559;
        double sn, cs; sincos_d((double)pos * f, sn, cs);
        ((f32x2*)(ws + WS_TAB))[id] = (f32x2){(float)cs, (float)sn};
    }
    { const f32x4* x4 = (const f32x4*)a.in[I_X]; u32x2* xb = (u32x2*)(ws + WS_XB);
      const size_t n4 = (size_t)S * DM / 4, stride = (size_t)F.G * NTHR;
      size_t i = (size_t)blockIdx.x * NTHR + F.tid;
      for (; i + 7 * stride < n4; i += 8 * stride) {
          f32x4 v[8];
#pragma unroll
          for (int j = 0; j < 8; ++j) v[j] = __builtin_nontemporal_load(x4 + i + j * stride);
#pragma unroll
          for (int j = 0; j < 8; ++j) xb[i + j * stride] = (u32x2){pk2(v[j].x, v[j].y), pk2(v[j].z, v[j].w)};
      }
      for (; i < n4; i += stride) { const f32x4 v = x4[i]; xb[i] = (u32x2){pk2(v.x, v.y), pk2(v.z, v.w)}; } }
    { u32x4* z = (u32x4*)(ws + WS_WMIN + (size_t)1088 * DM * 2); const size_t n = (size_t)(MLA_IN_PAD - 1088) * DM * 2 / 16;
      for (size_t i = (size_t)blockIdx.x * NTHR + F.tid; i < n; i += (size_t)F.G * NTHR) z[i] = (u32x4){0u, 0u, 0u, 0u}; }
    transpose_matrix<0>(F, a.in[I_AB_WIN], DM, AB_IN, (bf16_t*)(ws + WS_WIN), scr);
}
__device__ __forceinline__ void transpose_pair_bf16(const float* W, int K, int N, bf16_t* WT, int k0, int n0, LAS float* scr, int lane) {
    const int r8 = lane >> 3, c4 = (lane & 7) * 4;
    const float* src = W + (size_t)(k0 + r8) * N + n0 + c4;
    f32x4 va[8], vb[8];
#pragma unroll
    for (int i = 0; i < 8; ++i) va[i] = __builtin_nontemporal_load((const f32x4*)(src + (size_t)(8 * i) * N));
#pragma unroll
    for (int i = 0; i < 8; ++i) vb[i] = __builtin_nontemporal_load((const f32x4*)(src + (size_t)(64 + 8 * i) * N));
#pragma unroll
    for (int h = 0; h < 2; ++h) {
#pragma unroll
        for (int i = 0; i < 8; ++i) { const f32x4 v = h ? vb[i] : va[i]; LAS float* d = scr + (8 * i + r8) * 33 + c4; d[0] = v.x; d[1] = v.y; d[2] = v.z; d[3] = v.w; }
        LDS_WAIT(); asm volatile("" ::: "memory");
        const int c = lane & 7;
#pragma unroll
        for (int j = 0; j < 4; ++j) { const int n = (lane >> 3) + 8 * j; const LAS float* p = scr + (8 * c) * 33 + n;
            u32x4 o; o.x = pk2(p[0 * 33], p[1 * 33]); o.y = pk2(p[2 * 33], p[3 * 33]); o.z = pk2(p[4 * 33], p[5 * 33]); o.w = pk2(p[6 * 33], p[7 * 33]);
            *(u32x4*)(WT + (size_t)(n0 + n) * K + k0 + 64 * h + 8 * c) = o; }
        LDS_WAIT(); asm volatile("" ::: "memory");
    }
}
__device__ __forceinline__ void transpose_matrix_pairs_bf16(const float* W, int K, int N, bf16_t* WT, LAS float* scr, int gw, int ngw, int lane) {
    const int nblk = N / 32, nitems = (K / 128) * nblk;
    for (int it = gw; it < nitems; it += ngw) { const int kb = it / nblk, nb = it % nblk; transpose_pair_bf16(W, K, N, WT, 128 * kb, 32 * nb, scr, lane); }
}
constexpr int N_CONV = 64;
__device__ __forceinline__ void convert_experts(const Frame& F, const Args& a) {
    LAS float* scr = (LAS float*)(F.lds + RING_OFF + F.wave * 16384);
    unsigned char* ws = a.ws;
    const int gw = (int)blockIdx.x * NWAVES + F.wave, ngw = N_CONV * NWAVES;
    for (int le = 0; le < 2 * NE; ++le) {
        transpose_matrix_pairs_f8<1>(a.in[I_WGATE] + (size_t)le * DM * FF, DM, FF, (unsigned char*)(ws + WS_WGU) + (size_t)le * 2 * FF * DM, W8_GU, scr, gw, ngw, F.lane);
        transpose_matrix_pairs_f8<2>(a.in[I_WUP] + (size_t)le * DM * FF, DM, FF, (unsigned char*)(ws + WS_WGU) + (size_t)le * 2 * FF * DM, W8_GU, scr, gw, ngw, F.lane);
        transpose_matrix_pairs_f8<0>(a.in[I_WDOWN] + (size_t)le * FF * DM, FF, DM, (unsigned char*)(ws + WS_WD) + (size_t)le * DM * FF, W8_D, scr, gw, ngw, F.lane);
    }
    transpose_matrix_pairs_bf16(a.in[I_AB_WOUT], DM, DM, (bf16_t*)(ws + WS_WOUT), scr, gw, ngw, F.lane);
    transpose_matrix_pairs_bf16(a.in[I_M_WIN], DM, 1088, (bf16_t*)(ws + WS_WMIN), scr, gw, ngw, F.lane);
    transpose_matrix_pairs_bf16(a.in[I_M_WUQ], 512, 3072, (bf16_t*)(ws + WS_WUQ), scr, gw, ngw, F.lane);
    transpose_matrix_pairs_bf16(a.in[I_M_WUKV], 512, 4096, (bf16_t*)(ws + WS_WUKV), scr, gw, ngw, F.lane);
    transpose_matrix_pairs_bf16(a.in[I_M_WOUT], DM, DM, (bf16_t*)(ws + WS_WMOUT), scr, gw, ngw, F.lane);
}
__device__ __forceinline__ void phase_prep0(const Frame& F, const Args& a) {
    const float* HQK = (const float*)(a.ws + WS_SCR + SC_HQK);
    bf16_t* AQB = (bf16_t*)(a.ws + WS_SCR + SC_AQB); bf16_t* AKB = (bf16_t*)(a.ws + WS_SCR + SC_AKB);
    const f32x2* tab = (const f32x2*)(a.ws + WS_TAB);
    const int l = F.lane, half = l >> 5, ll = l & 31, i0 = (2 * ll) & 31;
    for (int p = F.gw; p < S * 10; p += F.NGW) {
        const int t = p / 10, hh = p % 10;
        const f32x2 v = *(const f32x2*)(HQK + (size_t)t * 1280 + hh * 128 + 2 * l);
        const float ss = wave_sum(v.x * v.x + v.y * v.y);
        const float r = 1.0f / sqrtf(ss * (1.f / 128) + NORM_EPS);
        const float* w = hh < 8 ? a.in[I_AB_QN] : a.in[I_AB_KN];
        const f32x2 g = *(const f32x2*)(w + 2 * l);
        const float y0 = v.x * r * g.x, y1 = v.y * r * g.y;
        const float q0 = __shfl_xor(y0, 16), q1 = __shfl_xor(y1, 16);
        const f32x2* cs = half == 0 ? tab + TAB_R128 + (t >> 6) * 32 + i0 : tab + TAB_C128 + (t & 63) * 32 + i0;
        const f32x2 c0 = cs[0], c1 = cs[1];
        float o0, o1;
        if (ll < 16) { o0 = y0 * c0.x - q0 * c0.y; o1 = y1 * c1.x - q1 * c1.y; }
        else         { o0 = y0 * c0.x + q0 * c0.y; o1 = y1 * c1.x + q1 * c1.y; }
        unsigned* dst = hh < 8 ? (unsigned*)(AQB + (size_t)t * 1024 + hh * 128) : (unsigned*)(AKB + (size_t)t * 256 + (hh - 8) * 128);
        dst[l] = pk2(o0, o1);
    }
    { const bf16_t* HB = (const bf16_t*)(a.ws + WS_SCR + SC_HB); unsigned* N2 = (unsigned*)(a.ws + WS_CTL) + CW_NORM2;
      float mq = 0.f, mk = 0.f;
      for (int t = F.gw; t < S; t += F.NGW) {
#pragma unroll
          for (int which = 0; which < 2; ++which) {
              const bf16x8* p = (const bf16x8*)(HB + (size_t)t * HB_LD + (which ? 1280 : 256) + 16 * l);
              const bf16x8 v0 = p[0], v1 = p[1]; float ss = 0.f;
#pragma unroll
              for (int e = 0; e < 8; ++e) { const float x = bf2f((unsigned short)v0[e]), y = bf2f((unsigned short)v1[e]); ss += x * x + y * y; }
              ss += __shfl_xor(ss, 1); ss += __shfl_xor(ss, 2); ss += __shfl_xor(ss, 4);
              if (which) mk = fmaxf(mk, ss); else mq = fmaxf(mq, ss);
          }
      }
      if ((l & 7) == 0) { atomicMax(&N2[l >> 3], __float_as_uint(mq)); atomicMax(&N2[8 + (l >> 3)], __float_as_uint(mk)); }
    }
}
template <bool FIX>
__device__ __forceinline__ void phase_attn0(const Frame& F, const Args& a, int qword) {
    unsigned char* sc = a.ws + WS_SCR;
    const bf16_t* AQB = (const bf16_t*)(sc + SC_AQB); const bf16_t* AKB = (const bf16_t*)(sc + SC_AKB); const bf16_t* HB = (const bf16_t*)(sc + SC_HB);
    bf16_t* CAT = (bf16_t*)(sc + SC_CAT); float* DO = (float*)(sc + SC_DO);
    constexpr int NU = 24 * 64;
    unsigned* qh = (unsigned*)(a.ws + WS_CTL) + CW_QHEAD0 + qword; unsigned* aflag = (unsigned*)(a.ws + WS_CTL) + CW_AFLAG; const float* N2 = (const float*)((const unsigned*)(a.ws + WS_CTL) + CW_NORM2);
    volatile LAS int* uslot = (volatile LAS int*)(F.lds + MISC_OFF + 64);
    for (;;) {
        if (F.tid == 0) uslot[0] = (int)__hip_atomic_fetch_add(qh, 1u, __ATOMIC_RELAXED, __HIP_MEMORY_SCOPE_AGENT);
        __syncthreads();
        const int u = uslot[0];
        __syncthreads();
        if (u >= NU) break;
        if (u < 512) {
            const int h = u >> 6, qb = u & 63, q0 = qb * 256, kvh = h >> 2;
            att::attn_ring<128, false, true, 1024, 256, HB_LD, DM, FIX>(AQB + (size_t)q0 * 1024 + h * 128, AKB + kvh * 128, HB + kvh * 128, nullptr,
                                                                          CAT + (size_t)q0 * DM + h * 128, q0, 0, S / 64, F.ldsg, 0.f, nullptr, nullptr, aflag);
        } else {
            const int r = u - 512, h = 3 - (r >> 8), d = (r >> 6) & 3, m = d >> 1, vh = d & 1, qb = r & 63, q0 = qb * 256;
            const float slope = __builtin_amdgcn_exp2f(-2.0f * (float)(h + 1));
            const float sig = FIX ? slope * 1.4426950408889634f : slope * 11.313708498984761f;
            const float Bb = sqrtf(N2[h * 2 + m] * N2[8 + h * 2 + m]) * 0.08838834764831845f;
            const float Df = (2.f * Bb + 112.f) / slope + 1.f;
            const int D = Df > 40000.f ? 40000 : (int)Df;
            int kt0 = (q0 - D) >> 6; if (kt0 < 0) kt0 = 0;
            int kt1 = ((q0 + 255 + D) >> 6) + 1; if (kt1 > S / 64) kt1 = S / 64;
            while ((kt1 - kt0) & 3) { if (kt1 < S / 64) ++kt1; else --kt0; }
            att::attn_ring<128, true, false, HB_LD, HB_LD, HB_LD, DM, FIX>(HB + (size_t)q0 * HB_LD + 256 + (h * 2 + m) * 128, HB + 1280 + (h * 2 + m) * 128, HB + 2304 + h * 256 + vh * 128, nullptr,
                                                                             DO + (size_t)q0 * DM + (h * 2 + m) * 256 + vh * 128, q0, kt0, kt1 - kt0, F.ldsg, sig, nullptr, nullptr, aflag);
        }
        __syncthreads();
    }
}
__device__ __forceinline__ void phase_combine(const Frame& F, const Args& a) {
    const float* DO = (const float*)(a.ws + WS_SCR + SC_DO); bf16_t* CAT = (bf16_t*)(a.ws + WS_SCR + SC_CAT);
    const int l = F.lane;
    const float s1 = wave_sum(a.in[I_LQ1][l] * a.in[I_LK1][l] + a.in[I_LQ1][l + 64] * a.in[I_LK1][l + 64]);
    const float s2 = wave_sum(a.in[I_LQ2][l] * a.in[I_LK2][l] + a.in[I_LQ2][l + 64] * a.in[I_LK2][l + 64]);
    const float lam_init = 0.2f;
    const float lam = expf(s1) - expf(s2) + lam_init;
    const f32x4 sg = *(const f32x4*)(a.in[I_SUBLN] + 4 * l);
    for (int p = F.gw; p < S * 4; p += F.NGW) {
        const int t = p >> 2, h = p & 3;
        const f32x4 o1 = *(const f32x4*)(DO + (size_t)t * DM + (h * 2) * 256 + 4 * l), o2 = *(const f32x4*)(DO + (size_t)t * DM + (h * 2 + 1) * 256 + 4 * l);
        const f32x4 o = o1 - o2 * lam;
        const float ss = wave_sum(o.x * o.x + o.y * o.y + o.z * o.z + o.w * o.w);
        const float r = (1.0f / sqrtf(ss * (1.f / 256) + NORM_EPS));
        const float k = 1.f - lam_init;
        *(u32x2*)(CAT + (size_t)t * DM + 1024 + h * 256 + 4 * l) = (u32x2){pk2(o.x * r * sg.x * k, o.y * r * sg.y * k), pk2(o.z * r * sg.z * k, o.w * r * sg.w * k)};
    }
}
__device__ __forceinline__ void phase_ln_router(const Frame& F, const Args& a, int layer) {
    LAS float* wl = (LAS float*)(F.lds + RING_OFF);
    const float* wr = a.in[I_ROUTER] + (size_t)layer * DM * NE;
    { const f32x4* wr4 = (const f32x4*)wr;
#pragma unroll 8
      for (int m = F.tid; m < DM * NE / 4; m += NTHR) { const f32x4 w = wr4[m]; LAS float* d = wl + (4 * (m & 3)) * DM + (m >> 2); d[0] = w.x; d[DM] = w.y; d[2 * DM] = w.z; d[3 * DM] = w.w; } }
    __syncthreads();
    float* Y = (float*)(a.ws + WS_X1); unsigned char* XB8 = (unsigned char*)(a.ws + WS_XB); float* AFF = (float*)(a.ws + WS_SEL + SEL_AFF);
    const float* G = a.in[I_LNM_G] + layer * DM; const float* Bv = a.in[I_LNM_B] + layer * DM;
    const int l = F.lane;
    for (int t = F.gw; t < S; t += F.NGW) {
        f32x4* yr = (f32x4*)(Y + (size_t)t * DM) + l;
        f32x4 v[8]; float s = 0.f;
#pragma unroll
        for (int j = 0; j < 8; ++j) { v[j] = yr[64 * j]; s += (v[j].x + v[j].y) + (v[j].z + v[j].w); }
        const float mean = wave_sum(s) * (1.f / DM); float s2 = 0.f;
#pragma unroll
        for (int j = 0; j < 8; ++j) { v[j] = v[j] - mean; s2 += (v[j].x * v[j].x + v[j].y * v[j].y) + (v[j].z * v[j].z + v[j].w * v[j].w); }
        const float rstd = 1.f / sqrtf(wave_sum(s2) * (1.f / DM) + LN_EPS);
        unsigned* xb = (unsigned*)(XB8 + (size_t)t * DM) + l;
#pragma unroll
        for (int j = 0; j < 8; ++j) { const f32x4 g = *((const f32x4*)G + 64 * j + l), b = *((const f32x4*)Bv + 64 * j + l);
            v[j] = v[j] * rstd * g + b; yr[64 * j] = v[j]; xb[64 * j] = pk4_fp8(v[j].x, v[j].y, v[j].z, v[j].w); }
        float ac[NE];
#pragma unroll
        for (int e = 0; e < NE; ++e) { float acc = 0.f;
#pragma unroll
            for (int j = 0; j < 8; ++j) { const f32x4 w = *((const LAS f32x4*)(wl + e * DM) + 64 * j + l); acc += (v[j].x * w.x + v[j].y * w.y) + (v[j].z * w.z + v[j].w * w.w); }
            ac[e] = acc; __builtin_amdgcn_sched_barrier(0); }
        float k8[8], k4[4], k2[2], k1;
        const bool b5 = l & 32, b4 = l & 16, b3 = l & 8, b2 = l & 4;
#pragma unroll
        for (int i = 0; i < 8; ++i) { const float send = b5 ? ac[i] : ac[8 + i], keep = b5 ? ac[8 + i] : ac[i]; k8[i] = keep + __shfl_xor(send, 32); }
#pragma unroll
        for (int i = 0; i < 4; ++i) { const float send = b4 ? k8[i] : k8[4 + i], keep = b4 ? k8[4 + i] : k8[i]; k4[i] = keep + __shfl_xor(send, 16); }
#pragma unroll
        for (int i = 0; i < 2; ++i) { const float send = b3 ? k4[i] : k4[2 + i], keep = b3 ? k4[2 + i] : k4[i]; k2[i] = keep + __shfl_xor(send, 8); }
        { const float send = b2 ? k2[0] : k2[1], keep = b2 ? k2[1] : k2[0]; k1 = keep + __shfl_xor(send, 4); }
        k1 += __shfl_xor(k1, 2); k1 += __shfl_xor(k1, 1);
        const int my_e = (b5 ? 8 : 0) + (b4 ? 4 : 0) + (b3 ? 2 : 0) + (b2 ? 1 : 0);
        const float mx = wave_max(k1);
        const float p = expf(k1 - mx);
        const float sum = wave_sum(p) * 0.25f;
        if ((l & 3) == 0) AFF[(size_t)t * NE + my_e] = p / sum;
    }
    __syncthreads();
}
__device__ __forceinline__ void phase_topk(const Frame& F, const Args& a) {
    if (blockIdx.x >= NE) return;
    const int e = blockIdx.x, tid = F.tid, l = F.lane;
    LAS unsigned* keys = (LAS unsigned*)(F.lds + RING_OFF);
    LAS unsigned* hist = keys + 16896;
    LAS unsigned* sel = hist + 8 * 257 + 8;
    LAS unsigned* wtot = sel + 8;
    const float* AFF = (const float*)(a.ws + WS_SEL + SEL_AFF);
    int* IDX = (int*)(a.ws + WS_SEL + SEL_IDX); float* GATE = (float*)(a.ws + WS_SEL + SEL_GATE); int* TOKSLOT = (int*)(a.ws + WS_SEL + SEL_TOKSLOT);
    for (int i = tid; i < S; i += NTHR) keys[i + (i >> 5)] = __float_as_uint(AFF[(size_t)i * NE + e]);
    if (tid == 0) { sel[0] = 0u; sel[1] = (unsigned)CAP; }
    __syncthreads();
    for (int pass = 0; pass < 4; ++pass) {
        const int shift = 24 - 8 * pass;
        for (int i = tid; i < 8 * 257; i += NTHR) hist[i] = 0u;
        __syncthreads();
        const unsigned prefix = sel[0], mask = pass == 0 ? 0u : (0xFFFFFFFFu << (shift + 8));
        for (int i = tid; i < S; i += NTHR) { const unsigned k = keys[i + (i >> 5)];
            if ((k & mask) == prefix) __hip_atomic_fetch_add(&hist[(l & 7) * 257 + ((k >> shift) & 255u)], 1u, __ATOMIC_RELAXED, __HIP_MEMORY_SCOPE_WORKGROUP); }
        __syncthreads();
        if (F.wave == 0) {
            const unsigned remaining = sel[1];
            unsigned h0 = 0u, h1 = 0u, h2 = 0u, h3 = 0u;
#pragma unroll
            for (int cp = 0; cp < 8; ++cp) { h0 += hist[cp * 257 + 255 - 4 * l]; h1 += hist[cp * 257 + 254 - 4 * l]; h2 += hist[cp * 257 + 253 - 4 * l]; h3 += hist[cp * 257 + 252 - 4 * l]; }
            const unsigned sm = h0 + h1 + h2 + h3;
            unsigned incl = sm;
#pragma unroll
            for (int o = 1; o < 64; o <<= 1) { const unsigned n = __shfl_up(incl, o); if (l >= o) incl += n; }
            const unsigned excl = incl - sm;
            if (excl < remaining && remaining <= incl) {
                unsigned c = excl; int bin;
                if (c + h0 >= remaining) bin = 255 - 4 * l;
                else { c += h0; if (c + h1 >= remaining) bin = 254 - 4 * l; else { c += h1; if (c + h2 >= remaining) bin = 253 - 4 * l; else { c += h2; bin = 252 - 4 * l; } } }
                sel[0] = prefix | ((unsigned)bin << shift); sel[1] = remaining - c;
            }
        }
        __syncthreads();
    }
    const unsigned T = sel[0], need_eq = sel[1], n_gt = (unsigned)CAP - need_eq;
    unsigned gt = 0, eq = 0;
    for (int i = 0; i < 32; ++i) { const unsigned k = keys[33 * tid + i]; gt += (k > T) ? 1u : 0u; eq += (k == T) ? 1u : 0u; }
    const unsigned packed = gt | (eq << 16);
    unsigned incl = packed;
#pragma unroll
    for (int o = 1; o < 64; o <<= 1) { const unsigned n = __shfl_up(incl, o); if (l >= o) incl += n; }
    if (l == 63) wtot[F.wave] = incl;
    __syncthreads();
    unsigned base = incl - packed;
    for (int w = 0; w < F.wave; ++w) base += wtot[w];
    unsigned gbase = base & 0xFFFFu, ebase = base >> 16;
    for (int i = 0; i < 32; ++i) {
        const int tok = 32 * tid + i; const unsigned k = keys[33 * tid + i]; int slot = -1;
        if (k > T) slot = (int)(gbase++);
        else if (k == T) { if (ebase < need_eq) slot = (int)(n_gt + ebase); ++ebase; }
        TOKSLOT[(size_t)tok * NE + e] = slot;
        if (slot >= 0) { IDX[e * CAP + slot] = tok; GATE[e * CAP + slot] = __uint_as_float(k); }
    }
    __syncthreads();
}
__device__ __forceinline__ void phase_gather(const Frame& F, const Args& a) {
    const int* IDX = (const int*)(a.ws + WS_SEL + SEL_IDX);
    const u32x4* XB8 = (const u32x4*)(a.ws + WS_XB); u32x4* XIN = (u32x4*)(a.ws + WS_SCR + SC_XIN);
    for (int r = F.gw; r < NE * CAP; r += F.NGW) {
        const int tok = IDX[r];
        const u32x4* src = XB8 + (size_t)tok * (DM / 16) + F.lane; u32x4* dst = XIN + (size_t)r * (DM / 16) + F.lane;
        const u32x4 v0 = src[0], v1 = src[64];
        dst[0] = v0; dst[64] = v1;
    }
}
__device__ __forceinline__ void phase_ln2(const Frame& F, const Args& a, int layer, float* OUT, bool write_xb) {
    const float* X1 = (const float*)(a.ws + WS_X1); const bf16_t* YS = (const bf16_t*)(a.ws + WS_SCR + SC_YS);
    const int* TOKSLOT = (const int*)(a.ws + WS_SEL + SEL_TOKSLOT); bf16_t* XB = (bf16_t*)(a.ws + WS_XB);
    const float* G = a.in[I_LNF_G] + layer * DM; const float* Bv = a.in[I_LNF_B] + layer * DM;
    const int l = F.lane;
    for (int t = F.gw; t < S; t += F.NGW) {
        const f32x4* xr = (const f32x4*)(X1 + (size_t)t * DM) + l;
        f32x4 v[8];
#pragma unroll
        for (int j = 0; j < 8; ++j) v[j] = xr[64 * j] * ALPHA;
        const int myslot = TOKSLOT[(size_t)t * NE + (l & 15)];
        for (int e = 0; e < NE; ++e) {
            const int slot = __shfl(myslot, e);
            if (slot >= 0) { const u32x2* yr = (const u32x2*)(YS + ((size_t)e * CAP + slot) * DM) + l;
#pragma unroll
                for (int j = 0; j < 8; ++j) { const u32x2 y = yr[64 * j]; v[j] = v[j] + (f32x4){__uint_as_float(y.x << 16), __uint_as_float(y.x & 0xffff0000u), __uint_as_float(y.y << 16), __uint_as_float(y.y & 0xffff0000u)}; } }
        }
        float s = 0.f;
#pragma unroll
        for (int j = 0; j < 8; ++j) s += (v[j].x + v[j].y) + (v[j].z + v[j].w);
        const float mean = wave_sum(s) * (1.f / DM); float s2 = 0.f;
#pragma unroll
        for (int j = 0; j < 8; ++j) { v[j] = v[j] - mean; s2 += (v[j].x * v[j].x + v[j].y * v[j].y) + (v[j].z * v[j].z + v[j].w * v[j].w); }
        const float rstd = 1.f / sqrtf(wave_sum(s2) * (1.f / DM) + LN_EPS);
        f32x4* orow = (f32x4*)(OUT + (size_t)t * DM) + l; u32x2* xb = (u32x2*)(XB + (size_t)t * DM) + l;
#pragma unroll
        for (int j = 0; j < 8; ++j) { const f32x4 g = *((const f32x4*)G + 64 * j + l), b = *((const f32x4*)Bv + 64 * j + l);
            const f32x4 o = v[j] * rstd * g + b; orow[64 * j] = o; if (write_xb) xb[64 * j] = (u32x2){pk2(o.x, o.y), pk2(o.z, o.w)}; }
    }
}
__device__ __forceinline__ void phase_prep1(const Frame& F, const Args& a) {
    const float* H1 = (const float*)(a.ws + WS_SCR + SC_H1);
    bf16_t* CQN = (bf16_t*)(a.ws + WS_SCR + SC_CQN); bf16_t* CKVN = (bf16_t*)(a.ws + WS_SCR + SC_CKVN); bf16_t* KROPE = (bf16_t*)(a.ws + WS_SCR + SC_KROPE);
    const f32x2* tab = (const f32x2*)(a.ws + WS_TAB);
    const int l = F.lane;
    for (int t = F.gw; t < S; t += F.NGW) {
        const float* hr = H1 + (size_t)t * MLA_IN_PAD;
#pragma unroll
        for (int part = 0; part < 2; ++part) {
            const f32x4 v0 = *((const f32x4*)(hr + part * 512) + l), v1 = *((const f32x4*)(hr + part * 512) + 64 + l);
            const float ss = wave_sum((v0.x * v0.x + v0.y * v0.y) + (v0.z * v0.z + v0.w * v0.w) + (v1.x * v1.x + v1.y * v1.y) + (v1.z * v1.z + v1.w * v1.w));
            const float r = 1.0f / sqrtf(ss * (1.f / 512) + NORM_EPS);
            const float* w = part == 0 ? a.in[I_M_QN] : a.in[I_M_KVN];
            const f32x4 g0 = *((const f32x4*)w + l), g1 = *((const f32x4*)w + 64 + l);
            bf16_t* dst = (part == 0 ? CQN : CKVN) + (size_t)t * 512;
            *((u32x2*)dst + l) = (u32x2){pk2(v0.x * r * g0.x, v0.y * r * g0.y), pk2(v0.z * r * g0.z, v0.w * r * g0.w)};
            *((u32x2*)dst + 64 + l) = (u32x2){pk2(v1.x * r * g1.x, v1.y * r * g1.y), pk2(v1.z * r * g1.z, v1.w * r * g1.w)};
        }
        const float y = hr[1024 + l];
        const float q = __shfl_xor(y, 16);
        const int half = l >> 5, ll = l & 31, i = ll & 15;
        const f32x2 cs = half == 0 ? tab[TAB_R64 + (t >> 6) * 16 + i] : tab[TAB_C64 + (t & 63) * 16 + i];
        const float o = ll < 16 ? y * cs.x - q * cs.y : y * cs.x + q * cs.y;
        KROPE[(size_t)t * 64 + l] = (bf16_t)f2bf(o);
    }
}
template <bool FIX>
__device__ __forceinline__ void phase_attn1(const Frame& F, const Args& a) {
    unsigned char* sc = a.ws + WS_SCR;
    const bf16_t* QM = (const bf16_t*)(sc + SC_QM); const bf16_t* KVM = (const bf16_t*)(sc + SC_KVM); const bf16_t* KROPE = (const bf16_t*)(sc + SC_KROPE);
    bf16_t* AO = (bf16_t*)(sc + SC_AO);
    const f32x2* tab = (const f32x2*)(a.ws + WS_TAB);
    constexpr int NU = 16 * 64;
    for (int u = blockIdx.x; u < NU; u += F.G) {
        const int h = u >> 6, qb = u & 63, q0 = qb * 256;
        att::attn_ring<192, false, true, 3072, 4096, 4096, DM, FIX>(QM + (size_t)q0 * 3072 + h * 192, KVM + h * 256, KVM + h * 256 + 128, KROPE,
                                                                     AO + (size_t)q0 * DM + h * 128, q0, 0, S / 64, F.ldsg, 0.f, tab + TAB_R64, tab + TAB_C64, (unsigned*)(a.ws + WS_CTL) + CW_AFLAG + 1);
        __syncthreads();
    }
}


#ifndef SYN_MODE
#define SYN_MODE 0
#endif
#if SYN_MODE
__device__ __forceinline__ void phase_syn(const Frame& F, const Args& a) {
    const float* xin = a.in[I_X];
    bf16x8 fa = *(const bf16x8*)(xin + F.tid * 8), fb = *(const bf16x8*)(xin + 4096 + F.tid * 8);
    f32x16 c0 = {}, c1 = {};
    float v[10];
#pragma unroll
    for (int i = 0; i < 10; ++i) v[i] = xin[8192 + F.tid + 512 * i];
    const float k1 = xin[1], k2 = xin[2];
    constexpr int T = 1000;
#if SYN_MODE == 5
    if (F.wave >= 4) { for (int t = 0; t < 8; ++t) { _Pragma("unroll") for (int i = 0; i < 10; ++i) asm volatile("v_fma_f32 %0, %0, %1, %2" : "+v"(v[i]) : "v"(k1), "v"(k2)); __builtin_amdgcn_sched_barrier(0); } }
#endif
    for (int t = 0; t < T; ++t) {
#pragma unroll
        for (int m = 0; m < 16; ++m) {
#if SYN_MODE == 1 || SYN_MODE == 3 || SYN_MODE == 5
            if (m & 1) c1 = __builtin_amdgcn_mfma_f32_32x32x16_bf16(fa, fb, c1, 0, 0, 0); else c0 = __builtin_amdgcn_mfma_f32_32x32x16_bf16(fa, fb, c0, 0, 0, 0);
#endif
#if SYN_MODE == 4
            if (m & 1) asm volatile("v_mfma_f32_32x32x16_bf16 %0, %1, %2, %0" : "+a"(c1) : "v"(fa), "v"(fb)); else asm volatile("v_mfma_f32_32x32x16_bf16 %0, %1, %2, %0" : "+a"(c0) : "v"(fa), "v"(fb));
#endif
#if SYN_MODE >= 2
#pragma unroll
            for (int i = 0; i < 5; ++i) asm volatile("v_fma_f32 %0, %0, %1, %2" : "+v"(v[(m * 5 + i) % 10]) : "v"(k1), "v"(k2));
#endif
            __builtin_amdgcn_sched_barrier(0);
        }
    }
    float sacc = 0.f;
#pragma unroll
    for (int i = 0; i < 10; ++i) sacc += v[i];
#pragma unroll
    for (int r = 0; r < 16; ++r) sacc += c0[r] + c1[r];
    ((float*)(a.ws + WS_END))[blockIdx.x * NTHR + F.tid] = sacc;
}
#endif
constexpr int N_PHASES = 23;
#ifndef PH_MASK
#define PH_MASK 0x1FFFF
#endif
#define IN(k) (((PH_MASK >> (k)) & 1) && lo <= (k) && (k) < hi)
#define INM(j) (((PH_MASK >> (6 + (j))) & 1) && lo <= (pb + (j)) && (pb + (j)) < hi)
#ifndef DUP_BARRIER
#define DUP_BARRIER 0
#endif
#define SEAM(k) do { if (lo <= (k) && (k) + 1 < hi) { xcd_barrier(bar); if (DUP_BARRIER) xcd_barrier(bar); } } while (0)
#ifndef DUP_SMALL
#define DUP_SMALL 0
#endif
#define DUPS(bit, stmt) do { if ((DUP_SMALL >> (bit)) & 1) { xcd_barrier(bar); stmt; } } while (0)

template <int LAYER>
__device__ __forceinline__ void run_layer(const Frame& F, const Args& args, const XcdBarrier& bar, const int lo, const int hi) {
    unsigned char* ws = args.ws; unsigned char* sc = ws + WS_SCR;
    if constexpr (LAYER == 0) {
        if (IN(1)) {
            pg8::Gemm g{(const bf16_t*)(ws + WS_XB), (const bf16_t*)(ws + WS_WIN), S, AB_IN, DM}; pg8::StaticOrder So; So.init(S, AB_IN, F.G, (int)blockIdx.x);
            pg8::EpiIn0 E{(float*)(sc + SC_HQK), (bf16_t*)(sc + SC_HB)};
            pg8::gemm_phase<pg8::EpiIn0, pg8::StaticOrder>(F.lds + RING_OFF, g, So, E); DUPS(7, (pg8::gemm_phase<pg8::EpiIn0, pg8::StaticOrder>(F.lds + RING_OFF, g, So, E))); SEAM(1);
        }
        if (IN(2)) { phase_prep0(F, args); DUPS(0, phase_prep0(F, args)); SEAM(2); }
        if (IN(3)) {
#ifndef FORCE_FALLBACK
#define FORCE_FALLBACK 0
#endif
            if ((int)blockIdx.x < N_CONV) { convert_experts(F, args); __syncthreads(); }
            phase_attn0<true>(F, args, 0); if (FORCE_FALLBACK && F.tid == 0) atomicOr((unsigned*)(args.ws + WS_CTL) + CW_AFLAG, 1u); xcd_barrier(bar);
            if (__hip_atomic_load((unsigned*)(args.ws + WS_CTL) + CW_AFLAG, __ATOMIC_RELAXED, __HIP_MEMORY_SCOPE_AGENT) != 0u) { phase_attn0<false>(F, args, 32); SEAM(3); }
            }
        if (IN(4)) { phase_combine(F, args); DUPS(1, phase_combine(F, args)); SEAM(4); }
        if (IN(5)) {
            pg8::Gemm g{(const bf16_t*)(sc + SC_CAT), (const bf16_t*)(ws + WS_WOUT), S, DM, DM}; pg8::StaticOrder So; So.init(S, DM, F.G, (int)blockIdx.x);
            pg8::EpiResid E{args.in[I_X], (float*)(ws + WS_X1)};
            pg8::gemm_phase<pg8::EpiResid, pg8::StaticOrder>(F.lds + RING_OFF, g, So, E); DUPS(8, (pg8::gemm_phase<pg8::EpiResid, pg8::StaticOrder>(F.lds + RING_OFF, g, So, E))); SEAM(5);
        }
    } else {
        if (IN(12)) {
            pg8::Gemm g{(const bf16_t*)(ws + WS_XB), (const bf16_t*)(ws + WS_WMIN), S, MLA_IN_PAD, DM}; pg8::StaticOrder So; So.init(S, MLA_IN_PAD, F.G, (int)blockIdx.x);
            pg8::EpiF32 E{(float*)(sc + SC_H1), MLA_IN_PAD};
            pg8::gemm_phase<pg8::EpiF32, pg8::StaticOrder>(F.lds + RING_OFF, g, So, E); DUPS(9, (pg8::gemm_phase<pg8::EpiF32, pg8::StaticOrder>(F.lds + RING_OFF, g, So, E))); SEAM(12);
        }
        if (IN(13)) { phase_prep1(F, args); DUPS(2, phase_prep1(F, args)); SEAM(13); }
        if (IN(14)) {
            static_assert(SC_CKVN == SC_CQN + (size_t)S * 512 * 2 && WS_WUKV == WS_WUQ + (size_t)3072 * 512 * 2, "the two up-projections' operands must be contiguous");
            pg8::Gemm g{(const bf16_t*)(sc + SC_CQN), (const bf16_t*)(ws + WS_WUQ), 2 * S, 7168, 512}; pg8::UpOrder So; So.init(F.G, (int)blockIdx.x);
            pg8::EpiUp E{(bf16_t*)(sc + SC_QM), (bf16_t*)(sc + SC_KVM)};
            pg8::gemm_phase<pg8::EpiUp, pg8::UpOrder>(F.lds + RING_OFF, g, So, E); DUPS(10, (pg8::gemm_phase<pg8::EpiUp, pg8::UpOrder>(F.lds + RING_OFF, g, So, E))); SEAM(14);
        }
#ifndef DUP_ATTN1
#define DUP_ATTN1 0
#endif
        if (IN(15)) {
            phase_attn1<true>(F, args); if (FORCE_FALLBACK && F.tid == 0) atomicOr((unsigned*)(args.ws + WS_CTL) + CW_AFLAG + 1, 1u); xcd_barrier(bar);
            if (__hip_atomic_load((unsigned*)(args.ws + WS_CTL) + CW_AFLAG + 1, __ATOMIC_RELAXED, __HIP_MEMORY_SCOPE_AGENT) != 0u) { phase_attn1<false>(F, args); SEAM(15); }
            }
        if (IN(16)) {
            pg8::Gemm g{(const bf16_t*)(sc + SC_AO), (const bf16_t*)(ws + WS_WMOUT), S, DM, DM}; pg8::StaticOrder So; So.init(S, DM, F.G, (int)blockIdx.x);
            pg8::EpiResid E{(const float*)(ws + WS_X2), (float*)(ws + WS_X1)};
            pg8::gemm_phase<pg8::EpiResid, pg8::StaticOrder>(F.lds + RING_OFF, g, So, E); DUPS(11, (pg8::gemm_phase<pg8::EpiResid, pg8::StaticOrder>(F.lds + RING_OFF, g, So, E))); SEAM(16);
        }
    }
    constexpr int pb = LAYER == 0 ? 6 : 17;
    if (INM(0)) { phase_ln_router(F, args, LAYER); SEAM(pb + 0); }
    if (INM(1)) { phase_topk(F, args); DUPS(3, phase_topk(F, args)); SEAM(pb + 1); }
    if (INM(3)) {
        pg8::Gemm g{(const bf16_t*)(ws + WS_XB), (const bf16_t*)((const unsigned char*)(ws + WS_WGU) + (size_t)LAYER * NE * 2 * FF * DM), NE * CAP, NE * 2 * FF, DM / 2, (const int*)(ws + WS_SEL + SEL_IDX)};
        pg8::GroupOrder So; So.init(16, F.G, (int)blockIdx.x);
        pg8::EpiSwiglu E{(unsigned char*)(sc + SC_HID)};
#ifndef DUP_GU
#define DUP_GU 0
#endif
        pg8::gemm_phase<pg8::EpiSwiglu, pg8::GroupOrder, true, true, true>(F.lds + RING_OFF, g, So, E);
        if (DUP_GU) { xcd_barrier(bar); pg8::gemm_phase<pg8::EpiSwiglu, pg8::GroupOrder, true, true, true>(F.lds + RING_OFF, g, So, E); }
        SEAM(pb + 3);
    }
    if (INM(4)) {
        pg8::Gemm g{(const bf16_t*)(sc + SC_HID), (const bf16_t*)((const unsigned char*)(ws + WS_WD) + (size_t)LAYER * NE * DM * FF), NE * CAP, NE * DM, FF / 2};
        pg8::GroupOrder So; So.init(8, F.G, (int)blockIdx.x);
        pg8::EpiDown E{(bf16_t*)(sc + SC_YS), (const float*)(ws + WS_SEL + SEL_GATE)};
        pg8::gemm_phase<pg8::EpiDown, pg8::GroupOrder, true, true>(F.lds + RING_OFF, g, So, E); DUPS(12, (pg8::gemm_phase<pg8::EpiDown, pg8::GroupOrder, true, true>(F.lds + RING_OFF, g, So, E))); SEAM(pb + 4);
    }
    if (INM(5)) { phase_ln2(F, args, LAYER, LAYER == 0 ? (float*)(ws + WS_X2) : args.out, LAYER == 0); DUPS(5, phase_ln2(F, args, LAYER, LAYER == 0 ? (float*)(ws + WS_X2) : args.out, LAYER == 0)); SEAM(pb + 5); }
}

__global__ void __launch_bounds__(NTHR, 2) mk_fwd(Args args) {
    extern __shared__ __attribute__((aligned(16))) unsigned char lds[];
    Frame F;
    F.lds = (LAS unsigned char*)lds; F.ldsg = (char*)lds;
    F.tid = threadIdx.x; F.lane = F.tid & 63; F.wave = __builtin_amdgcn_readfirstlane(F.tid >> 6);
    F.G = gridDim.x; F.gw = blockIdx.x * NWAVES + F.wave; F.NGW = F.G * NWAVES;
    volatile LAS unsigned* MISC = (volatile LAS unsigned*)(F.lds + MISC_OFF);
    for (int u = F.tid; u < (LDS_BYTES - LDSCTL_OFF) / 4; u += NTHR) ((LAS unsigned*)(F.lds + LDSCTL_OFF))[u] = 0u;
    __syncthreads();
    const int lo = args.ph_lo, hi = args.ph_hi;
    XcdBarrier bar = xcd_barrier_post((unsigned*)(args.ws + WS_CTL) + CW_BAR + lo * XCD_BAR_WORDS, MISC + 8);
#ifndef DUP_PROLOGUE
#define DUP_PROLOGUE 0
#endif
#if SYN_MODE
    if (IN(0)) { phase_syn(F, args); }
#endif
    if (IN(0)) { phase_prologue(F, args); if (DUP_PROLOGUE) { xcd_barrier(bar); phase_prologue(F, args); } SEAM(0); }
    run_layer<0>(F, args, bar, lo, hi);
    run_layer<1>(F, args, bar, lo, hi);
}
#undef IN
#undef INM
#undef SEAM

#ifdef SELFCHECK
constexpr size_t WS_CHK = 512 * 1024;
__device__ __forceinline__ unsigned hsh(unsigned x) { x ^= x >> 16; x *= 0x7feb352du; x ^= x >> 15; x *= 0x846ca68bu; x ^= x >> 16; return x; }
__device__ __forceinline__ float bfr(float x) { return bf2f((unsigned short)f2bf(x)); }
__device__ __forceinline__ void chk_commit(float* chk, int id, float err, float mag) {
    atomicMax((unsigned*)&chk[2 * id], __float_as_uint(err)); atomicMax((unsigned*)&chk[2 * id + 1], __float_as_uint(mag));
}
__device__ float blk_sum(float v, float* red) {
    v = wave_sum(v); __syncthreads(); if ((threadIdx.x & 63) == 0) red[threadIdx.x >> 6] = v; __syncthreads(); return red[0] + red[1] + red[2] + red[3];
}
__device__ float blk_max(float v, float* red) {
    v = wave_max(v); __syncthreads(); if ((threadIdx.x & 63) == 0) red[threadIdx.x >> 6] = v; __syncthreads(); return fmaxf(fmaxf(red[0], red[1]), fmaxf(red[2], red[3]));
}
__global__ void chk_gemm(int id, const bf16_t* A, const float* Af, int K, const float* W, int N, int n_lo, int n_hi, const float* outF, const bf16_t* outB, int ldo, int ocol0, const float* R, float* chk) {
    __shared__ float red[4];
    const unsigned hs = hsh(blockIdx.x * 977u + id * 131u + 7u);
    const int t = blockIdx.x == 0 ? 0 : (blockIdx.x == 1 ? S - 1 : (int)(hs % S)), n = n_lo + (int)(hsh(hs) % (unsigned)(n_hi - n_lo));
    float acc = 0.f;
    for (int k = threadIdx.x; k < K; k += 256) { const float a = Af ? bfr(Af[(size_t)t * K + k]) : bf2f(A[(size_t)t * K + k]); acc += a * bfr(W[(size_t)k * N + n]); }
    float ref = blk_sum(acc, red);
    if (threadIdx.x == 0) {
        float got = outF ? outF[(size_t)t * ldo + n - ocol0] : bf2f(outB[(size_t)t * ldo + n - ocol0]);
        if (R) got -= ALPHA * R[(size_t)t * DM + n];
        chk_commit(chk, id, fabsf(got - ref), fabsf(ref)); }
}
__device__ void rope_cs(int pos, int i, int n, float& c, float& s) { double f = 1.0; const double b = 0.7498942093324559; const int st = (n == 64) ? i : 2 * i; for (int j = 0; j < st; ++j) f *= b; double sn, cs; sincos_d((double)pos * f, sn, cs); c = (float)cs; s = (float)sn; }
__device__ float axial_rope_elem(const float* v, int D, int d, int t) {
    const int half = D / 2, hq = half / 2; const int blk = d / half, ld = d % half; const int pos = blk == 0 ? (t >> 6) : (t & 63);
    const int i = ld % hq; float c, s; rope_cs(pos, i, half, c, s);
    const float x1 = v[blk * half + i], x2 = v[blk * half + hq + i];
    return ld < hq ? x1 * c - x2 * s : x2 * c + x1 * s;
}
__global__ void chk_prep0(const float* HQK, const float* qn, const float* kn, const bf16_t* AQB, const bf16_t* AKB, float* chk) {
    __shared__ float red[4]; __shared__ float y[128];
    const unsigned hs = hsh(blockIdx.x * 7919u + 3u); const int t = blockIdx.x < 2 ? (blockIdx.x ? S - 1 : 0) : (int)(hs % S), hh = (int)(hsh(hs) % 10u);
    const int d = threadIdx.x & 127; const float v = HQK[(size_t)t * 1280 + hh * 128 + d];
    const float ss = blk_sum(threadIdx.x < 128 ? v * v : 0.f, red);
    if (threadIdx.x < 128) y[d] = v * (1.0f / sqrtf(ss / 128.f + NORM_EPS)) * (hh < 8 ? qn[d] : kn[d]);
    __syncthreads();
    float err = 0.f, mag = 0.f;
    if (threadIdx.x < 128) { const float ref = axial_rope_elem(y, 128, d, t); const float got = hh < 8 ? bf2f(AQB[(size_t)t * 1024 + hh * 128 + d]) : bf2f(AKB[(size_t)t * 256 + (hh - 8) * 128 + d]); err = fabsf(got - ref); mag = fabsf(ref); }
    err = blk_max(err, red); mag = blk_max(mag, red);
    if (threadIdx.x == 0) chk_commit(chk, 1, err, mag);
}
__global__ void chk_prep1(const float* H1, const float* qn, const float* kvn, const bf16_t* CQN, const bf16_t* CKVN, const bf16_t* KROPE, float* chk) {
    __shared__ float red[4]; __shared__ float kr[64];
    const unsigned hs = hsh(blockIdx.x * 7919u + 5u); const int t = blockIdx.x < 2 ? (blockIdx.x ? S - 1 : 0) : (int)(hs % S);
    const float* hr = H1 + (size_t)t * MLA_IN_PAD; float err = 0.f, mag = 0.f;
    for (int part = 0; part < 2; ++part) {
        const float a = hr[part * 512 + threadIdx.x], b = hr[part * 512 + 256 + threadIdx.x];
        const float ss = blk_sum(a * a + b * b, red); const float r = 1.0f / sqrtf(ss / 512.f + NORM_EPS);
        const float* w = part ? kvn : qn; const bf16_t* o = (part ? CKVN : CQN) + (size_t)t * 512;
        const float r0 = a * r * w[threadIdx.x], r1 = b * r * w[256 + threadIdx.x];
        err = fmaxf(err, fmaxf(fabsf(bf2f(o[threadIdx.x]) - r0), fabsf(bf2f(o[256 + threadIdx.x]) - r1))); mag = fmaxf(mag, fmaxf(fabsf(r0), fabsf(r1)));
    }
    if (threadIdx.x < 64) kr[threadIdx.x] = hr[1024 + threadIdx.x];
    __syncthreads();
    if (threadIdx.x < 64) { const float ref = axial_rope_elem(kr, 64, threadIdx.x, t); err = fmaxf(err, fabsf(bf2f(KROPE[(size_t)t * 64 + threadIdx.x]) - ref)); mag = fmaxf(mag, fabsf(ref)); }
    err = blk_max(err, red); mag = blk_max(mag, red);
    if (threadIdx.x == 0) chk_commit(chk, 5, err, mag);
}
template <int MODE>
__global__ void chk_attn(int id, const bf16_t* Q, const bf16_t* Kb, const bf16_t* Vb, const bf16_t* KR, const bf16_t* O, float* chk) {
    __shared__ float red[4]; __shared__ float q[192]; __shared__ float qt[64]; __shared__ float sc[S];
    constexpr int H = MODE == 0 ? 8 : 16, DQ = MODE == 0 ? 128 : 192;
    const unsigned hs = hsh(blockIdx.x * 104729u + id); const int t = blockIdx.x < 2 ? (blockIdx.x ? S - 1 : 0) : (int)(hs % S), h = (int)(hsh(hs) % (unsigned)H);
    const int ldq = MODE == 0 ? 1024 : 3072, ldk = MODE == 0 ? 256 : 4096, ldv = MODE == 0 ? HB_LD : 4096;
    const int qo = MODE == 0 ? h * 128 : h * 192, ko = MODE == 0 ? (h >> 2) * 128 : h * 256, vo = MODE == 0 ? (h >> 2) * 128 : h * 256 + 128;
    if (threadIdx.x < DQ) q[threadIdx.x] = bf2f(Q[(size_t)t * ldq + qo + threadIdx.x]);
    __syncthreads();
    if (MODE == 1) { if (threadIdx.x < 64) qt[threadIdx.x] = bfr(axial_rope_elem(q + 128, 64, threadIdx.x, t)); __syncthreads(); if (threadIdx.x < 64) q[128 + threadIdx.x] = qt[threadIdx.x]; __syncthreads(); }
    const float scale = MODE == 0 ? 0.08838834764831845f : 0.07216878364870322f;
    float mx = -3e38f;
    for (int j = threadIdx.x; j < S; j += 256) { float a = 0.f;
        for (int d = 0; d < 128; ++d) a += q[d] * bf2f(Kb[(size_t)j * ldk + ko + d]);
        if (MODE == 1) for (int d = 0; d < 64; ++d) a += q[128 + d] * bf2f(KR[(size_t)j * 64 + d]);
        a *= scale; sc[j] = a; mx = fmaxf(mx, a); }
    mx = blk_max(mx, red);
    float sm = 0.f;
    for (int j = threadIdx.x; j < S; j += 256) { const float p = expf(sc[j] - mx); sc[j] = p; sm += p; }
    sm = blk_sum(sm, red);
    float err = 0.f, mag = 0.f;
    if (threadIdx.x < 128) { float o = 0.f; for (int j = 0; j < S; ++j) o += sc[j] * bf2f(Vb[(size_t)j * ldv + vo + threadIdx.x]); o /= sm;
        err = fabsf(bf2f(O[(size_t)t * DM + h * 128 + threadIdx.x]) - o); mag = fabsf(o); }
    err = blk_max(err, red); mag = blk_max(mag, red);
    if (threadIdx.x == 0) chk_commit(chk, id, err, mag);
}
__global__ void chk_report(const float* chk, float* out) {
    if (threadIdx.x || blockIdx.x) return;
    const float tol[10] = {0.02f, 0.02f, 0.05f, 0.02f, 0.02f, 0.02f, 0.02f, 0.02f, 0.05f, 0.02f};
    for (int c = 0; c < 10; ++c) { const float err = chk[2 * c], mag = chk[2 * c + 1]; const float rel = mag > 0.f ? err / mag : 9.f;
        if (!(rel <= tol[c])) { int dg = 0; float r = rel; while (r < 1.f && dg < 9) { r *= 10.f; ++dg; } out[0] = (float)(10 * (c + 1) + dg) * 1000.f; return; } }
}
#endif
extern "C" void kernel_launch(void* const* d_in, const int* in_sizes, int n_in, void* d_out, int out_size, void* d_ws, size_t ws_size, hipStream_t stream) {
    static int grid = 0;
    if (grid == 0) {
        if (n_in != N_IN || in_sizes[0] != S * DM || out_size != S * DM || ws_size < WS_END + MiB) {
            fprintf(stderr, "kernel_launch: unexpected shapes: n_in %d in0 %d out %d ws %zu (need %zu)\n", n_in, n_in > 0 ? in_sizes[0] : -1, out_size, ws_size, (size_t)WS_END); grid = -1; return; }
        int dev = 0, cus = 0, per_cu = 0;
        if (hipGetDevice(&dev) != hipSuccess || hipDeviceGetAttribute(&cus, hipDeviceAttributeMultiprocessorCount, dev) != hipSuccess) { grid = -1; return; }
        if (hipFuncSetAttribute((const void*)mk_fwd, hipFuncAttributeMaxDynamicSharedMemorySize, LDS_BYTES) != hipSuccess) { fprintf(stderr, "kernel_launch: hipFuncSetAttribute failed\n"); grid = -1; return; }
        if (hipOccupancyMaxActiveBlocksPerMultiprocessor(&per_cu, (const void*)mk_fwd, NTHR, LDS_BYTES) != hipSuccess || per_cu < 1) { fprintf(stderr, "kernel_launch: occupancy query says %d\n", per_cu); }
        (void)hipGetLastError();
        grid = cus;
    }
    if (grid < 0) return;
    if (hipMemsetAsync((char*)d_ws + WS_CTL, 0, CTL_ZERO_BYTES, stream) != hipSuccess) return;
    Args a{};
    for (int i = 0; i < N_IN; ++i) a.in[i] = (const float*)d_in[i];
    a.out = (float*)d_out; a.ws = (unsigned char*)d_ws;
#ifdef SELFCHECK
    {
        unsigned char* ws = (unsigned char*)d_ws; unsigned char* sc = ws + WS_SCR; float* chk = (float*)(ws + WS_CHK);
        auto run = [&](int lo, int hi) { for (int p = lo; p < hi; ++p) { a.ph_lo = p; a.ph_hi = p + 1; hipLaunchKernelGGL(mk_fwd, dim3(grid), dim3(NTHR), LDS_BYTES, stream, a); } };
        run(0, 6);
        hipLaunchKernelGGL(chk_gemm, dim3(96), dim3(256), 0, stream, 0, (const bf16_t*)nullptr, a.in[I_X], DM, a.in[I_AB_WIN], AB_IN, 0, 1280, (const float*)(sc + SC_HQK), (const bf16_t*)nullptr, 1280, 0, (const float*)nullptr, chk);
        hipLaunchKernelGGL(chk_gemm, dim3(96), dim3(256), 0, stream, 3, (const bf16_t*)nullptr, a.in[I_X], DM, a.in[I_AB_WIN], AB_IN, 1280, AB_IN, (const float*)nullptr, (const bf16_t*)(sc + SC_HB), HB_LD, 1280, (const float*)nullptr, chk);
        hipLaunchKernelGGL(chk_prep0, dim3(96), dim3(256), 0, stream, (const float*)(sc + SC_HQK), a.in[I_AB_QN], a.in[I_AB_KN], (const bf16_t*)(sc + SC_AQB), (const bf16_t*)(sc + SC_AKB), chk);
        hipLaunchKernelGGL(chk_attn<0>, dim3(48), dim3(256), 0, stream, 2, (const bf16_t*)(sc + SC_AQB), (const bf16_t*)(sc + SC_AKB), (const bf16_t*)(sc + SC_HB), (const bf16_t*)nullptr, (const bf16_t*)(sc + SC_CAT), chk);
        run(6, 17);
        hipLaunchKernelGGL(chk_gemm, dim3(96), dim3(256), 0, stream, 4, (const bf16_t*)(ws + WS_XB), (const float*)nullptr, DM, a.in[I_M_WIN], 1088, 0, 1088, (const float*)(sc + SC_H1), (const bf16_t*)nullptr, MLA_IN_PAD, 0, (const float*)nullptr, chk);
        hipLaunchKernelGGL(chk_prep1, dim3(96), dim3(256), 0, stream, (const float*)(sc + SC_H1), a.in[I_M_QN], a.in[I_M_KVN], (const bf16_t*)(sc + SC_CQN), (const bf16_t*)(sc + SC_CKVN), (const bf16_t*)(sc + SC_KROPE), chk);
        hipLaunchKernelGGL(chk_gemm, dim3(96), dim3(256), 0, stream, 6, (const bf16_t*)(sc + SC_CQN), (const float*)nullptr, 512, a.in[I_M_WUQ], 3072, 0, 3072, (const float*)nullptr, (const bf16_t*)(sc + SC_QM), 3072, 0, (const float*)nullptr, chk);
        hipLaunchKernelGGL(chk_gemm, dim3(96), dim3(256), 0, stream, 7, (const bf16_t*)(sc + SC_CKVN), (const float*)nullptr, 512, a.in[I_M_WUKV], 4096, 0, 4096, (const float*)nullptr, (const bf16_t*)(sc + SC_KVM), 4096, 0, (const float*)nullptr, chk);
        hipLaunchKernelGGL(chk_attn<1>, dim3(48), dim3(256), 0, stream, 8, (const bf16_t*)(sc + SC_QM), (const bf16_t*)(sc + SC_KVM), (const bf16_t*)(sc + SC_KVM), (const bf16_t*)(sc + SC_KROPE), (const bf16_t*)(sc + SC_AO), chk);
        hipLaunchKernelGGL(chk_gemm, dim3(96), dim3(256), 0, stream, 9, (const bf16_t*)(sc + SC_AO), (const float*)nullptr, DM, a.in[I_M_WOUT], DM, 0, DM, (const float*)(ws + WS_X1), (const bf16_t*)nullptr, DM, 0, (const float*)(ws + WS_X2), chk);
        run(17, N_PHASES);
        hipLaunchKernelGGL(chk_report, dim3(1), dim3(64), 0, stream, (const float*)chk, (float*)d_out);
    }
#elif MK_ONE_LAUNCH
    a.ph_lo = 0; a.ph_hi = N_PHASES;
    hipLaunchKernelGGL(mk_fwd, dim3(grid), dim3(NTHR), LDS_BYTES, stream, a);
#else
    for (int p = 0; p < N_PHASES; ++p) { a.ph_lo = p; a.ph_hi = p + 1; hipLaunchKernelGGL(mk_fwd, dim3(grid), dim3(NTHR), LDS_BYTES, stream, a); }
#endif
    const hipError_t le = hipPeekAtLastError();
    if (le != hipSuccess) fprintf(stderr, "kernel_launch: launch failed: %s\n", hipGetErrorName(le));
}
```
